# Optimizing an MI355X kernel written in HIP

```python
import jax
import jax.numpy as jnp
from jax import lax
import numpy as np

D_MODEL = 2048
BATCH = 2
SEQ = 8192
DEPTH = 1

MIX_WIDTH = D_MODEL
HGRN_WIDTH = MIX_WIDTH // 2
HGRN_HEAD_DIM = 128
HGRN_HEADS = HGRN_WIDTH // HGRN_HEAD_DIM
HGRN_CHUNK = 64
ATTN_WIDTH = MIX_WIDTH - HGRN_WIDTH
ATTN_HEAD_DIM = 64
ATTN_Q_HEADS = ATTN_WIDTH // ATTN_HEAD_DIM
ATTN_KV_HEADS = 4
ATTN_GROUP = ATTN_Q_HEADS // ATTN_KV_HEADS
WINDOW = 128
ATTN_BLOCK = 128
REL_BUCKETS = 32
REL_MAX_DIST = 128
D_FF = -(-8 * D_MODEL // (3 * 256)) * 256
KV_WIDTH = ATTN_KV_HEADS * ATTN_HEAD_DIM
IN_SPLITS = (HGRN_WIDTH, HGRN_WIDTH, HGRN_WIDTH, HGRN_WIDTH, ATTN_WIDTH, KV_WIDTH, KV_WIDTH)
IN_WIDTH = sum(IN_SPLITS)
EPS = 1e-6
NEG_INF = -1e30

kernel_name = "hymba_hgrn2_swa_sink_adaln"


def rms_norm(x, w):
    xf = x.astype(jnp.float32)
    y = xf * lax.rsqrt(jnp.mean(xf * xf, axis=-1, keepdims=True) + EPS)
    return (y * w.astype(jnp.float32)).astype(x.dtype)


def t5_causal_buckets(dist):
    max_exact = REL_BUCKETS // 2
    d = np.maximum(dist, 0)
    log_b = max_exact + (np.log(np.maximum(d, 1) / max_exact)
                         / np.log(REL_MAX_DIST / max_exact)
                         * (REL_BUCKETS - max_exact)).astype(np.int32)
    log_b = np.minimum(log_b, REL_BUCKETS - 1)
    return np.where(d < max_exact, d, log_b).astype(np.int32)


def hgrn2_chunkwise(q, f_logit, i_in, lb):
    B, S, _ = q.shape
    C, H, dk = HGRN_CHUNK, HGRN_HEADS, HGRN_HEAD_DIM
    N = S // C
    f = lb + (1.0 - lb) * jax.nn.sigmoid(f_logit.astype(jnp.float32))
    k = 1.0 - f
    log_f = jnp.log(f)

    def heads(t):
        return t.astype(jnp.float32).reshape(B, N, C, H, dk)

    qc, kc, vc, gc = heads(q), heads(k), heads(i_in), heads(log_f)
    b = jnp.cumsum(gc, axis=2)
    b_mid = b[:, :, C // 2 - 1:C // 2]
    q_rel = qc * jnp.exp(b - b_mid)
    k_rel = kc * jnp.exp(b_mid - b)
    causal = jnp.asarray(np.tril(np.ones((C, C), dtype=bool)))
    a = jnp.einsum('bnthd,bnshd->bnhts', q_rel, k_rel)
    a = jnp.where(causal, a, 0.0)
    o_intra = jnp.einsum('bnhts,bnshe->bnthe', a, vc)

    b_last = b[:, :, -1]
    k_dec = kc * jnp.exp(b_last[:, :, None] - b)
    kv = jnp.einsum('bnshd,bnshe->bnhde', k_dec, vc)
    decay = jnp.exp(b_last)

    def step(state, inp):
        dec, kv_n = inp
        return dec[..., None] * state + kv_n, state

    s0 = jnp.zeros((B, H, dk, dk), jnp.float32)
    _, s_prev = lax.scan(step, s0, (jnp.moveaxis(decay, 1, 0), jnp.moveaxis(kv, 1, 0)))
    s_prev = jnp.moveaxis(s_prev, 0, 1)
    o_inter = jnp.einsum('bnthd,bnhde->bnthe', qc * jnp.exp(b), s_prev)
    return (o_intra + o_inter).reshape(B, S, H, dk)


def sliding_window_gqa(q, k, v, sinks, rel_table):
    B, S, _ = q.shape
    L, Hkv, G, dh = ATTN_BLOCK, ATTN_KV_HEADS, ATTN_GROUP, ATTN_HEAD_DIM
    NB = S // L
    qb = q.reshape(B, NB, L, Hkv, G, dh)
    pad = ((0, 0), (L, 0), (0, 0))
    kp = jnp.pad(k, pad).reshape(B, NB + 1, L, Hkv, dh)
    vp = jnp.pad(v, pad).reshape(B, NB + 1, L, Hkv, dh)
    kb = jnp.concatenate([kp[:, :-1], kp[:, 1:]], axis=2)
    vb = jnp.concatenate([vp[:, :-1], vp[:, 1:]], axis=2)

    scores = jnp.einsum('bnqhgd,bnkhd->bnhgqk', qb, kb).astype(jnp.float32) * (dh ** -0.5)
    qi = np.arange(L)[:, None]
    kj = np.arange(2 * L)[None, :]
    dist = qi + L - kj
    in_window = (dist >= 0) & (dist < WINDOW)
    key_pos = np.arange(NB)[:, None] * L - L + np.arange(2 * L)[None, :]
    valid = in_window[None] & (key_pos >= 0)[:, None, :]
    bias = rel_table[t5_causal_buckets(dist)].astype(jnp.float32)
    bias = jnp.transpose(bias, (2, 0, 1)).reshape(Hkv, G, L, 2 * L)
    scores = jnp.where(jnp.asarray(valid)[None, :, None, None], scores + bias, NEG_INF)
    sink = sinks.astype(jnp.float32).reshape(Hkv, G)[None, None, :, :, None, None]
    sink = jnp.broadcast_to(sink, scores.shape[:-1] + (1,))
    probs = jax.nn.softmax(jnp.concatenate([scores, sink], axis=-1), axis=-1)[..., :-1]
    out = jnp.einsum('bnhgqk,bnkhd->bnqhgd', probs.astype(v.dtype), vb)
    return out.reshape(B, S, Hkv * G * dh)


def setup_inputs(seed: int = 0) -> dict:
    key = jax.random.key(seed)
    ks = jax.random.split(key, 16)

    def nrm(k, shape, scale):
        return jax.random.normal(k, shape, jnp.float32) * scale

    return {
        "x": nrm(ks[0], (BATCH, SEQ, D_MODEL), 1.0),
        "c": nrm(ks[1], (BATCH, D_MODEL), 1.0),
        "w_ada": nrm(ks[2], (DEPTH, D_MODEL, 6 * D_MODEL), 0.5 * D_MODEL ** -0.5),
        "b_ada": nrm(ks[3], (DEPTH, 6 * D_MODEL), 0.01),
        "norm1_w": 1.0 + nrm(ks[4], (DEPTH, D_MODEL), 0.02),
        "w_in": nrm(ks[5], (DEPTH, D_MODEL, IN_WIDTH), D_MODEL ** -0.5),
        "lower_bounds": nrm(ks[6], (DEPTH + 1, HGRN_WIDTH), 0.5),
        "hgrn_norm_w": 1.0 + nrm(ks[7], (DEPTH, HGRN_WIDTH), 0.02),
        "attn_sinks": nrm(ks[8], (DEPTH, ATTN_Q_HEADS), 1.0),
        "rel_bias_table": nrm(ks[9], (REL_BUCKETS, ATTN_Q_HEADS), 0.5),
        "w_out": nrm(ks[10], (DEPTH, MIX_WIDTH, D_MODEL), MIX_WIDTH ** -0.5),
        "norm2_w": 1.0 + nrm(ks[11], (DEPTH, D_MODEL), 0.02),
        "w_gate": nrm(ks[12], (DEPTH, D_MODEL, D_FF), D_MODEL ** -0.5),
        "w_up": nrm(ks[13], (DEPTH, D_MODEL, D_FF), D_MODEL ** -0.5),
        "w_down": nrm(ks[14], (DEPTH, D_FF, D_MODEL), D_FF ** -0.5),
        "final_norm_w": 1.0 + nrm(ks[15], (D_MODEL,), 0.02),
    }


def reference(x, c, w_ada, b_ada, norm1_w, w_in, lower_bounds, hgrn_norm_w, attn_sinks,
              rel_bias_table, w_out, norm2_w, w_gate, w_up, w_down, final_norm_w):
    B, S, _ = x.shape
    offsets = list(np.cumsum(IN_SPLITS)[:-1])
    lb_all = jnp.cumsum(jax.nn.softmax(lower_bounds.astype(jnp.float32), axis=0), axis=0)
    c_act = jax.nn.silu(c)
    for layer in range(DEPTH):
        mod = c_act @ w_ada[layer] + b_ada[layer]
        shift1, scale1, gate1, shift2, scale2, gate2 = jnp.split(mod[:, None, :], 6, axis=-1)

        h = rms_norm(x, norm1_w[layer]) * (1 + scale1) + shift1
        proj = h @ w_in[layer]
        hq, hf, hi, hg, aq, ak, av = jnp.split(proj, offsets, axis=-1)

        o_rec = hgrn2_chunkwise(hq, hf, hi, lb_all[layer])
        o_rec = o_rec * lax.rsqrt(jnp.mean(o_rec * o_rec, axis=-1, keepdims=True) + EPS)
        o_rec = o_rec.reshape(B, S, HGRN_WIDTH) * hgrn_norm_w[layer].astype(jnp.float32)
        o_rec = (o_rec * jax.nn.silu(hg.astype(jnp.float32))).astype(x.dtype)

        o_att = sliding_window_gqa(aq, ak, av, attn_sinks[layer], rel_bias_table)

        mixed = jnp.concatenate([o_rec, o_att], axis=-1)
        x = x + gate1 * (mixed @ w_out[layer])

        h = rms_norm(x, norm2_w[layer]) * (1 + scale2) + shift2
        ffn = (jax.nn.silu(h @ w_gate[layer]) * (h @ w_up[layer])) @ w_down[layer]
        x = x + gate2 * ffn
    return rms_norm(x, final_norm_w)
```

```cpp
#include <hip/hip_runtime.h>
#include <cstdio>
#include <cstdint>
namespace pg8 {
#define PG8_LAS __attribute__((address_space(3)))
typedef unsigned short bf16_t;
typedef short bf16x8 __attribute__((ext_vector_type(8)));
typedef float f32x4 __attribute__((ext_vector_type(4)));
typedef unsigned u32x4 __attribute__((ext_vector_type(4)));
constexpr int BM = 256, BK = 64, HALF = 128, HTB = HALF * BK * 2  , STAGE_BYTES = 8 * HTB, NXCD = 8, WGM = 8;

__host__ __device__ __forceinline__ int lds_byte(int r, int c) { const int st = (r >> 4) * 2 + (c >> 5), rr = r & 15, cc = c & 31, ob = rr * 64 + cc * 2; return st * 1024 + (ob ^ (((ob >> 9) & 1) << 5)); }
__host__ __device__ __forceinline__ void stage_rc(int b, int& R, int& C) { const int st = b / 1024, sb = b % 1024, swz = sb ^ (((sb >> 9) & 1) << 5); R = (st >> 1) * 16 + swz / 64; C = (st & 1) * 32 + (swz % 64) / 2; }
__host__ __device__ __forceinline__ int perm32(int rho) { const int n = rho >> 4, i = rho & 15; return 8 * (i >> 2) + 4 * n + (i & 3); }

struct Unit { int pm, pn; };
struct Gemm { const bf16_t* A; const bf16_t* Bt; int M, N, K; };

struct StaticOrder {
    int nM, nN, nwg, G, c;
    __host__ __device__ void init(int M, int N, int G_, int c_) { nM = M / BM; nN = N / BM; nwg = nM * nN; G = G_; c = c_; }
    __host__ __device__ bool next(int i, Unit& u) const {
        const long L = (long)i * G + c; if (L >= nwg) return false;
        int wgid = (int)L; { const int q = nwg / NXCD, r = nwg % NXCD, xcd = wgid % NXCD, off = wgid / NXCD; wgid = (xcd < r ? xcd * (q + 1) : r * (q + 1) + (xcd - r) * q) + off; }
        const int nig = WGM * nN, gid = wgid / nig, fm = gid * WGM, gsz = (nM - fm) < WGM ? (nM - fm) : WGM;
        u.pm = fm + ((wgid % nig) % gsz); u.pn = (wgid % nig) / gsz; return true;
    }
    __device__ __forceinline__ void a_ready(const Unit&) const {}
    __device__ __forceinline__ void done(const Unit&) const {}
};


__device__ __forceinline__ unsigned cvt_pk_bf16(float lo, float hi) { unsigned r; asm volatile("v_cvt_pk_bf16_f32 %0, %1, %2" : "=v"(r) : "v"(lo), "v"(hi)); return r; }

struct EpiBf16Plain {
    static constexpr bool PERM = true, AFTER_DRAIN = false;
    bf16_t* O; int ldc;
    __device__ __forceinline__ void operator()(const f32x4 (&acc)[2][2][4][2], const Unit& u, int wr, int wc, int fr, int fq) const {
        const int row0 = u.pm * BM + wr * 64 + fr, col0 = u.pn * BM + wc * 32 + 8 * fq;
#pragma unroll
        for (int ai = 0; ai < 2; ++ai)
#pragma unroll
            for (int m = 0; m < 4; ++m) { bf16_t* rowp = O + (size_t)(row0 + ai * HALF + m * 16) * ldc + col0;
#pragma unroll
                for (int bj = 0; bj < 2; ++bj) { const f32x4 v0 = acc[ai][bj][m][0], v1 = acc[ai][bj][m][1];
                    u32x4 w; w.x = cvt_pk_bf16(v0[0], v0[1]); w.y = cvt_pk_bf16(v0[2], v0[3]); w.z = cvt_pk_bf16(v1[0], v1[1]); w.w = cvt_pk_bf16(v1[2], v1[3]);
                    *(u32x4*)(rowp + bj * HALF) = w; } }
    }
};
struct EpiResGate {
    static constexpr bool PERM = false, AFTER_DRAIN = false;
    const float* base; float* out; int ldc; const float* gacc; const float* gbias; int gstride; int pm_per_batch;
    __device__ __forceinline__ void operator()(const f32x4 (&acc)[2][2][4][2], const Unit& u, int wr, int wc, int fr, int fq) const {
        const int col0 = u.pn * BM + wc * 32 + 4 * fq; const int b = u.pm / pm_per_batch;
        f32x4 gv[2][2];
#pragma unroll
        for (int bj = 0; bj < 2; ++bj)
#pragma unroll
            for (int n = 0; n < 2; ++n) gv[bj][n] = *(const f32x4*)(gacc + (size_t)b * gstride + col0 + bj * HALF + n * 16) + *(const f32x4*)(gbias + col0 + bj * HALF + n * 16);
#pragma unroll
        for (int ai = 0; ai < 2; ++ai)
#pragma unroll
            for (int m = 0; m < 4; ++m) { const size_t off = (size_t)(u.pm * BM + ai * HALF + wr * 64 + m * 16 + fr) * ldc + col0;
#pragma unroll
                for (int bj = 0; bj < 2; ++bj)
#pragma unroll
                    for (int n = 0; n < 2; ++n) { const f32x4 bs = *(const f32x4*)(base + off + bj * HALF + n * 16);
                        *(f32x4*)(out + off + bj * HALF + n * 16) = bs + gv[bj][n] * acc[ai][bj][m][n]; } }
    }
};
struct EpiSwiGLU {
    static constexpr bool PERM = true, AFTER_DRAIN = false;
    bf16_t* O; int ldc;
    __device__ __forceinline__ void operator()(const f32x4 (&acc)[2][2][4][2], const Unit& u, int wr, int wc, int fr, int fq) const {
        const int row0 = u.pm * BM + wr * 64 + fr, col0 = u.pn * HALF + wc * 32 + 8 * fq;
#pragma unroll
        for (int ai = 0; ai < 2; ++ai)
#pragma unroll
            for (int m = 0; m < 4; ++m) { bf16_t* rowp = O + (size_t)(row0 + ai * HALF + m * 16) * ldc + col0;
                float r[8];
#pragma unroll
                for (int n = 0; n < 2; ++n)
#pragma unroll
                    for (int j = 0; j < 4; ++j) { const float g = acc[ai][0][m][n][j], up = acc[ai][1][m][n][j];
                        const float sg = g * __builtin_amdgcn_rcpf(1.0f + __builtin_amdgcn_exp2f(-1.4426950408889634f * g)); r[n * 4 + j] = sg * up; }
                u32x4 w; w.x = cvt_pk_bf16(r[0], r[1]); w.y = cvt_pk_bf16(r[2], r[3]); w.z = cvt_pk_bf16(r[4], r[5]); w.w = cvt_pk_bf16(r[6], r[7]);
                *(u32x4*)(rowp) = w; }
    }
};

template <class Epi, class Sched, bool ALIGN_EPI = false, bool SP2 = false>
__device__ __forceinline__ void gemm_phase(PG8_LAS unsigned char* lds, const Gemm g, const Sched& S, const Epi& E) {
    const int tid = threadIdx.x, wid = __builtin_amdgcn_readfirstlane(tid >> 6), lane = tid & 63, wr = wid >> 2, wc = wid & 3, fr = lane & 15, fq = lane >> 4;
    const int K = g.K, nt = K / BK;
    unsigned voffA[2], voffB[2];
#pragma unroll
    for (int i = 0; i < 2; ++i) { int R, C; stage_rc(tid * 16 + i * 8192, R, C); const int Rb = Epi::PERM ? ((R & ~31) + perm32(R & 31)) : R;
        voffA[i] = (unsigned)(R * K + C) * 2u; voffB[i] = (unsigned)(Rb * K + C) * 2u; }
    const size_t kstep = (size_t)(BK * 2);
    const size_t hstep = (size_t)HALF * K * 2;
    const size_t tstep = 2 * hstep;
    const unsigned ldsw = (unsigned)wid * 1024u;
    const int aoff = lds_byte(wr * 64 + fr, fq * 8), boff = lds_byte(wc * 32 + fr, fq * 8);
#define PG8_SA(b, h) (((b) * 2 + (h)) * HTB)
#define PG8_SB(b, h) ((4 + (b) * 2 + (h)) * HTB)
#define PG8_STAGE(bufoff, gbase, voff) do { _Pragma("unroll") for (int _i = 0; _i < 2; ++_i) \
        __builtin_amdgcn_global_load_lds((const unsigned*)((const char*)(gbase) + (voff)[_i]), (PG8_LAS unsigned*)(lds + (bufoff) + ldsw + _i * 8192), 16, 0, 0); } while (0)
#define PG8_LDA(dst, b, h) do { _Pragma("unroll") for (int m = 0; m < 4; ++m) _Pragma("unroll") for (int k = 0; k < 2; ++k) dst[m][k] = *(const PG8_LAS bf16x8*)(lds + PG8_SA(b, h) + aoff + m * 2048 + k * 1024); } while (0)
#define PG8_LDB(dst, b, h) do { _Pragma("unroll") for (int n = 0; n < 2; ++n) _Pragma("unroll") for (int k = 0; k < 2; ++k) dst[n][k] = *(const PG8_LAS bf16x8*)(lds + PG8_SB(b, h) + boff + n * 2048 + k * 1024); } while (0)
#define PG8_MMA(ai, bj, At, Bt) do { __builtin_amdgcn_s_setprio(1); _Pragma("unroll") for (int m = 0; m < 4; ++m) _Pragma("unroll") for (int n = 0; n < 2; ++n) _Pragma("unroll") for (int k = 0; k < 2; ++k) \
        acc[ai][bj][m][n] = __builtin_amdgcn_mfma_f32_16x16x32_bf16(Bt[n][k], At[m][k], acc[ai][bj][m][n], 0, 0, 0); __builtin_amdgcn_s_setprio(0); } while (0)
#define PG8_WAIT_V(n) asm volatile("s_waitcnt vmcnt(" #n ")" ::: "memory")
#define PG8_WAIT_L(n) asm volatile("s_waitcnt lgkmcnt(" #n ")" ::: "memory")
#define PG8_BAR __builtin_amdgcn_s_barrier()
#define PG8_SCHED __builtin_amdgcn_sched_barrier(0)
    Unit cur, nxt; int ui = 0;
    if (!S.next(0, cur)) return;
    f32x4 acc[2][2][4][2];
#pragma unroll
    for (int a = 0; a < 2; ++a)
#pragma unroll
        for (int b = 0; b < 2; ++b)
#pragma unroll
            for (int m = 0; m < 4; ++m)
#pragma unroll
                for (int n = 0; n < 2; ++n) acc[a][b][m][n] = (f32x4){0.f, 0.f, 0.f, 0.f};
    bf16x8 At[4][2], B0[2][2], B1[2][2];
    const char* cA = (const char*)g.A + (size_t)cur.pm * tstep; const char* cB = (const char*)g.Bt + (size_t)cur.pn * tstep;
    S.a_ready(cur);
    if constexpr (SP2) {
        PG8_STAGE(PG8_SB(0, 0), cB, voffB); PG8_STAGE(PG8_SB(0, 1), cB + hstep, voffB); PG8_STAGE(PG8_SA(0, 0), cA, voffA); PG8_STAGE(PG8_SA(0, 1), cA + hstep, voffA);
        if (wr == 1) PG8_BAR;
        PG8_WAIT_V(2); PG8_BAR;
        PG8_STAGE(PG8_SB(1, 0), cB + kstep, voffB); PG8_STAGE(PG8_SA(1, 0), cA + kstep, voffA); PG8_STAGE(PG8_SB(1, 1), cB + hstep + kstep, voffB);
        PG8_WAIT_V(6); PG8_BAR;
    } else {
        PG8_STAGE(PG8_SB(0, 0), cB, voffB); PG8_STAGE(PG8_SA(0, 0), cA, voffA); PG8_STAGE(PG8_SB(0, 1), cB + hstep, voffB); PG8_STAGE(PG8_SA(0, 1), cA + hstep, voffA);
        if (wr == 1) PG8_BAR;
        PG8_WAIT_V(4); PG8_BAR;
        PG8_STAGE(PG8_SB(1, 0), cB + kstep, voffB); PG8_STAGE(PG8_SA(1, 0), cA + kstep, voffA); PG8_STAGE(PG8_SB(1, 1), cB + hstep + kstep, voffB);
        PG8_WAIT_V(6); PG8_BAR;
    }
    for (;;) {
        const bool has_next = S.next(ui + 1, nxt);
        const char* nA = has_next ? (const char*)g.A + (size_t)nxt.pm * tstep : cA; const char* nB = has_next ? (const char*)g.Bt + (size_t)nxt.pn * tstep : cB;
        for (int t = 0; t < nt; t += 2) {
            const bool last = (t == nt - 2);
            const char* a1 = cA + (size_t)(t + 1) * kstep;
            const char* a2 = last ? nA : cA + (size_t)(t + 2) * kstep; const char* b2 = last ? nB : cB + (size_t)(t + 2) * kstep;
            const char* a3 = a2 + kstep; const char* b3 = b2 + kstep;
            if (last && has_next) S.a_ready(nxt);
            if constexpr (SP2) {
            PG8_LDB(B0, 0, 0); PG8_LDB(B1, 0, 1); PG8_SCHED; PG8_LDA(At, 0, 0); PG8_STAGE(PG8_SA(1, 1), a1 + hstep, voffA);
            PG8_WAIT_V(8); PG8_WAIT_L(0); PG8_BAR; PG8_MMA(0, 0, At, B0); PG8_MMA(0, 1, At, B1); PG8_BAR; PG8_SCHED;
            PG8_LDA(At, 0, 1); PG8_STAGE(PG8_SB(0, 0), b2, voffB); PG8_STAGE(PG8_SB(0, 1), b2 + hstep, voffB); PG8_STAGE(PG8_SA(0, 0), a2, voffA);
            PG8_WAIT_V(8); PG8_WAIT_L(0); PG8_BAR; PG8_MMA(1, 0, At, B0); PG8_MMA(1, 1, At, B1); PG8_BAR; PG8_SCHED;
            PG8_LDB(B0, 1, 0); PG8_LDB(B1, 1, 1); PG8_SCHED; PG8_LDA(At, 1, 0); PG8_STAGE(PG8_SA(0, 1), a2 + hstep, voffA);
            PG8_WAIT_V(8); PG8_WAIT_L(0); PG8_BAR; PG8_MMA(0, 0, At, B0); PG8_MMA(0, 1, At, B1); PG8_BAR; PG8_SCHED;
            PG8_LDA(At, 1, 1); PG8_STAGE(PG8_SB(1, 0), b3, voffB); PG8_STAGE(PG8_SB(1, 1), b3 + hstep, voffB); PG8_STAGE(PG8_SA(1, 0), a3, voffA);
            PG8_WAIT_V(8); PG8_WAIT_L(0); PG8_BAR; PG8_MMA(1, 0, At, B0); PG8_MMA(1, 1, At, B1); PG8_BAR; PG8_SCHED;
            } else {
            PG8_LDB(B0, 0, 0); PG8_SCHED; PG8_LDA(At, 0, 0); PG8_STAGE(PG8_SA(1, 1), a1 + hstep, voffA);
            PG8_WAIT_L(8); PG8_BAR; PG8_WAIT_L(0); PG8_MMA(0, 0, At, B0); PG8_BAR; PG8_SCHED;
            PG8_LDB(B1, 0, 1); PG8_STAGE(PG8_SB(0, 0), b2, voffB);
            PG8_BAR; PG8_WAIT_L(0); PG8_MMA(0, 1, At, B1); PG8_BAR;
            PG8_LDA(At, 0, 1); PG8_STAGE(PG8_SA(0, 0), a2, voffA);
            PG8_BAR; PG8_WAIT_L(0); PG8_MMA(1, 0, At, B0); PG8_BAR; PG8_SCHED;
            PG8_STAGE(PG8_SB(0, 1), b2 + hstep, voffB);
            PG8_WAIT_V(6); PG8_BAR; PG8_MMA(1, 1, At, B1); PG8_BAR;
            PG8_LDB(B0, 1, 0); PG8_SCHED; PG8_LDA(At, 1, 0); PG8_STAGE(PG8_SA(0, 1), a2 + hstep, voffA);
            PG8_WAIT_L(8); PG8_BAR; PG8_WAIT_L(0); PG8_MMA(0, 0, At, B0); PG8_BAR; PG8_SCHED;
            PG8_LDB(B1, 1, 1); PG8_STAGE(PG8_SB(1, 0), b3, voffB);
            PG8_BAR; PG8_WAIT_L(0); PG8_MMA(0, 1, At, B1); PG8_BAR;
            PG8_LDA(At, 1, 1); PG8_STAGE(PG8_SA(1, 0), a3, voffA);
            PG8_BAR; PG8_WAIT_L(0); PG8_MMA(1, 0, At, B0); PG8_BAR; PG8_SCHED;
            PG8_STAGE(PG8_SB(1, 1), b3 + hstep, voffB);
            PG8_WAIT_V(6); PG8_BAR; PG8_MMA(1, 1, At, B1); PG8_BAR;
            }
        }
        if constexpr (ALIGN_EPI) { if (wr == 0) PG8_BAR; }
        if constexpr (!Epi::AFTER_DRAIN) { E(acc, cur, wr, wc, fr, fq); S.done(cur); }
        if (!has_next) break;
#pragma unroll
        for (int a = 0; a < 2; ++a)
#pragma unroll
            for (int b = 0; b < 2; ++b)
#pragma unroll
                for (int m = 0; m < 4; ++m)
#pragma unroll
                    for (int n = 0; n < 2; ++n) acc[a][b][m][n] = (f32x4){0.f, 0.f, 0.f, 0.f};
        cur = nxt; cA = nA; cB = nB; ++ui;
        if constexpr (ALIGN_EPI) { if (wr == 1) PG8_BAR; }
    }
    PG8_WAIT_V(0);
    if constexpr (!ALIGN_EPI) { if (wr == 0) PG8_BAR; }
    PG8_BAR;
    if constexpr (Epi::AFTER_DRAIN) { E.fused(acc, cur, wr, wc, fr, fq, lds, wid, lane); S.done(cur); }
#undef PG8_SA
#undef PG8_SB
#undef PG8_STAGE
#undef PG8_LDA
#undef PG8_LDB
#undef PG8_MMA
#undef PG8_WAIT_V
#undef PG8_WAIT_L
#undef PG8_BAR
#undef PG8_SCHED
}
}
#define GAS __attribute__((address_space(1)))
#define LAS __attribute__((address_space(3)))
typedef unsigned short bf16;
typedef unsigned v4u __attribute__((ext_vector_type(4)));
typedef float f32x4 __attribute__((ext_vector_type(4)));
typedef short bf16x8 __attribute__((ext_vector_type(8)));
typedef GAS unsigned gu32;
typedef GAS unsigned long long gu64;
#define RLX_AGENT __ATOMIC_RELAXED, __HIP_MEMORY_SCOPE_AGENT
#define LDS_WAIT() asm volatile("s_waitcnt lgkmcnt(0)" ::: "memory")
#define VM_WAIT() asm volatile("s_waitcnt vmcnt(0)" ::: "memory")
__device__ __forceinline__ unsigned long long rt() { return __builtin_amdgcn_s_memrealtime(); }
__device__ __forceinline__ unsigned f2bf(float f) { unsigned u = __builtin_bit_cast(unsigned, f); return (u + 0x7fffu + ((u >> 16) & 1u)) >> 16; }
__device__ __forceinline__ unsigned pk2(float lo, float hi) { return f2bf(lo) | (f2bf(hi) << 16); }

#define XB_TMO      128
#define XB_XCNT(j)  (256  + 64 * (j))
#define XB_XSUB(j)  (1280 + 64 * (j))
#define XB_XGEN(j)  (2304 + 64 * (j))
#define XB_TOP      3328
#define XB_TOPGEN   3392
#define XCD_BAR_WORDS 3456
#define XB_SPIN_CAP (1u << 18)

__device__ __forceinline__ unsigned xb_ld(unsigned* p)              { return __hip_atomic_load(p, __ATOMIC_RELAXED, __HIP_MEMORY_SCOPE_AGENT); }
__device__ __forceinline__ unsigned xb_add(unsigned* p, unsigned v) { return __hip_atomic_fetch_add(p, v, __ATOMIC_RELAXED, __HIP_MEMORY_SCOPE_AGENT); }
__device__ __forceinline__ unsigned xb_xcc_id() { return (unsigned)__builtin_amdgcn_s_getreg((3 << 11) | 20) & 0xFu; }
#define XB_SPIN(cond, bar) do { unsigned _sp = 0; while (cond) { __builtin_amdgcn_s_sleep(1); \
    if ((++_sp & 255u) == 0u) { if (xb_ld(&(bar)[XB_TMO])) break; if (_sp > XB_SPIN_CAP) { atomicAdd(&(bar)[XB_TMO], 1u); break; } } } } while (0)

struct XcdBarrier {
    unsigned* bar; unsigned x;
    volatile LAS unsigned* st;
};

__device__ __forceinline__ XcdBarrier xcd_barrier_post(unsigned* bar, volatile LAS unsigned* st) {
    XcdBarrier b; b.bar = bar; b.x = xb_xcc_id(); b.st = st;
    if (threadIdx.x == 0) (void)xb_add(&bar[XB_XCNT(b.x)], 1u);
    return b;
}
__device__ __forceinline__ void xcd_barrier_complete(unsigned* bar, unsigned x, unsigned& nloc, unsigned& nx) {
    const unsigned G = gridDim.x * gridDim.y * gridDim.z;
    unsigned sum, cnt, mine, sp = 0u;
    for (;;) {
        sum = 0u; cnt = 0u; mine = 0u;
#pragma unroll
        for (unsigned j = 0; j < 16; ++j) { const unsigned c = xb_ld(&bar[XB_XCNT(j)]); sum += c; cnt += (c > 0u) ? 1u : 0u; mine = (j == x) ? c : mine; }
        if (sum == G) break;
        __builtin_amdgcn_s_sleep(1);
        if ((++sp & 255u) == 0u) { if (xb_ld(&bar[XB_TMO])) break; if (sp > XB_SPIN_CAP) { atomicAdd(&bar[XB_TMO], 1u); break; } }
    }
    nloc = mine > 0u ? mine : 1u; nx = cnt > 0u ? cnt : 1u;
}

__device__ __forceinline__ void xcd_barrier(const XcdBarrier& b) {
    asm volatile("s_waitcnt vmcnt(0)" ::: "memory");
    __syncthreads();
    if (threadIdx.x == 0) {
        unsigned* bar = b.bar;
        __builtin_amdgcn_s_waitcnt(0);
        unsigned nloc = b.st[0], nx = b.st[1];
        if (nloc == 0u) { xcd_barrier_complete(bar, b.x, nloc, nx); b.st[0] = nloc; b.st[1] = nx; }
        const unsigned old = xb_add(&bar[XB_XSUB(b.x)], 1u);
        const unsigned gen = old / nloc;
        if (old + 1u == (gen + 1u) * nloc) {
            __builtin_amdgcn_fence(__ATOMIC_RELEASE, "agent");
            asm volatile("s_waitcnt vmcnt(0)" ::: "memory");
            const unsigned og = xb_add(&bar[XB_TOP], 1u);
            const unsigned tg = og / nx;
            if (og + 1u == (tg + 1u) * nx) xb_add(&bar[XB_TOPGEN], 1u);
            else XB_SPIN(xb_ld(&bar[XB_TOPGEN]) == tg, bar);
            __builtin_amdgcn_fence(__ATOMIC_ACQUIRE, "agent");
            xb_add(&bar[XB_XGEN(b.x)], 1u);
            asm volatile("s_waitcnt vmcnt(0)" ::: "memory");
        } else {
            XB_SPIN(xb_ld(&bar[XB_XGEN(b.x)]) == gen, bar);
            __builtin_amdgcn_fence(__ATOMIC_ACQUIRE, "agent");
            asm volatile("s_waitcnt vmcnt(0)" ::: "memory");
        }
    }
    __syncthreads();
}


constexpr int NWAVES = 8;
constexpr int BATCH = 2, SEQ = 8192, DM = 2048, M = BATCH * SEQ;
constexpr int INW = 5632, DFF = 5632, HW = 1024, NHH = 8, HHD = 128, AQH = 16, AKV = 4, AHD = 64;
constexpr int COL_HQ = 0, COL_HF = 1024, COL_HI = 2048, COL_HG = 3072, COL_AQ = 4096, COL_AK = 5120, COL_AV = 5376;
constexpr int MODW = 6 * DM;
constexpr float EPS = 1e-6f;
constexpr size_t MiB = 1u << 20;
constexpr size_t WS_CTL = 0, CTL_ZERO_BYTES = 1 * MiB;
constexpr size_t WS_MOD = 512 * 1024;
constexpr size_t WS_WIN = 2 * MiB, WS_WOUT = 24 * MiB, WS_WGU = 32 * MiB, WS_WDN = 76 * MiB;
constexpr size_t WS_H = 100 * MiB;
constexpr size_t WS_MIX = 164 * MiB;
constexpr size_t WS_PROJ = 228 * MiB;
constexpr size_t WS_END = 404 * MiB;
constexpr int CW_TMO = 0, CW_CODE = 1, CW_BAR = 4096;
constexpr int RING_OFF = 0, RING_BYTES = 131072;
constexpr int LDSCTL_OFF = RING_BYTES, MISC_OFF = LDSCTL_OFF + 320;
constexpr int LDS_BYTES = 147456;

__device__ const int T5_BUCKET[128] = {0,1,2,3,4,5,6,7,8,9,10,11,12,13,14,15,16,16,16,17,17,18,18,18,19,19,19,20,20,20,20,21,21,21,21,22,22,22,22,22,23,23,23,23,23,23,24,24,24,24,24,24,25,25,25,25,25,25,25,26,26,26,26,26,26,26,26,27,27,27,27,27,27,27,27,27,27,28,28,28,28,28,28,28,28,28,28,29,29,29,29,29,29,29,29,29,29,29,29,30,30,30,30,30,30,30,30,30,30,30,30,30,30,31,31,31,31,31,31,31,31,31,31,31,31,31,31,31};

struct Frame {
    LAS unsigned char* lds;
    volatile LAS unsigned* MISC;
    gu32* ctl;
    int tid, lane, wave, vcu, G;
    const float *x, *c, *w_ada, *b_ada, *norm1_w, *w_in, *lower_bounds, *hgrn_norm_w, *sinks, *rel, *w_out, *norm2_w, *w_gate, *w_up, *w_down, *final_w;
    float* out; float* mod;
    bf16 *Wt_in, *Wt_out, *Wt_gu, *Wt_dn, *H, *MIX, *PROJ;
};
__device__ __forceinline__ float bf2f(bf16 v) { return __builtin_bit_cast(float, (unsigned)v << 16); }
__device__ __forceinline__ float wave_sum(float v) {
#pragma unroll
    for (int o = 1; o < 64; o <<= 1) v += __shfl_xor(v, o);
    return v;
}
__device__ __forceinline__ float sigmoidf_(float v) { return __builtin_amdgcn_rcpf(1.0f + __builtin_amdgcn_exp2f(-1.4426950408889634f * v)); }

__device__ __forceinline__ void p0_transpose_item(const float* W, int K, int N, bf16* WT, int drow, LAS float* scr, int k0, int n0, int lane) {
#pragma unroll 8
    for (int i = 0; i < 32; ++i) { const int kk = 2 * i + (lane >> 5); scr[kk * 33 + (lane & 31)] = W[(size_t)(k0 + kk) * N + n0 + (lane & 31)]; }
    LDS_WAIT(); asm volatile("" ::: "memory");
    const int c = lane & 7;
#pragma unroll
    for (int j = 0; j < 4; ++j) { const int n = (lane >> 3) + 8 * j; const LAS float* s = scr + (8 * c) * 33 + n;
        v4u o; o.x = pk2(s[0 * 33], s[1 * 33]); o.y = pk2(s[2 * 33], s[3 * 33]); o.z = pk2(s[4 * 33], s[5 * 33]); o.w = pk2(s[6 * 33], s[7 * 33]);
        *(GAS v4u*)(WT + (size_t)(drow + n) * K + k0 + 8 * c) = o; }
    LDS_WAIT(); asm volatile("" ::: "memory");
}
__device__ __forceinline__ void p0a_prologue(Frame& F) {
    LAS float* scr = (LAS float*)(F.lds + RING_OFF + F.wave * 16384);
    const int gw = F.vcu * NWAVES + F.wave, NGW = F.G * NWAVES;
    for (int it = gw; it < 48 * 32; it += NGW) {
        const int cg = it % 48, ks = it / 48; const int k0 = ks * 64;
        const float c0 = F.c[k0 + F.lane], c1 = F.c[DM + k0 + F.lane];
        const float s0 = c0 * sigmoidf_(c0), s1 = c1 * sigmoidf_(c1);
        f32x4 a0 = {0.f, 0.f, 0.f, 0.f}, a1 = {0.f, 0.f, 0.f, 0.f};
        const float* wp = F.w_ada + (size_t)k0 * MODW + cg * 256 + 4 * F.lane;
#pragma unroll 8
        for (int kk = 0; kk < 64; ++kk) {
            const f32x4 w = *(const f32x4*)(wp + (size_t)kk * MODW);
            const float t0 = __builtin_bit_cast(float, __builtin_amdgcn_readlane(__builtin_bit_cast(int, s0), kk));
            const float t1 = __builtin_bit_cast(float, __builtin_amdgcn_readlane(__builtin_bit_cast(int, s1), kk));
            a0 += w * t0; a1 += w * t1;
        }
        float* m0 = F.mod + cg * 256 + 4 * F.lane; float* m1 = m0 + MODW;
#pragma unroll
        for (int j = 0; j < 4; ++j) { atomicAdd(m0 + j, a0[j]); atomicAdd(m1 + j, a1[j]); }
    }
    constexpr int I_IN = (DM / 64) * (INW / 32), I_OUT = (DM / 64) * (DM / 32), I_G = (DM / 64) * (DFF / 32), I_DN = (DFF / 64) * (DM / 32);
    constexpr int NITEMS = I_IN + I_OUT + 2 * I_G + I_DN;
    for (int it = gw; it < NITEMS; it += NGW) {
        int r = it;
        if (r < I_IN) { const int nb = INW / 32, kb = r / nb, n0 = (r % nb) * 32; p0_transpose_item(F.w_in, DM, INW, F.Wt_in, n0, scr, kb * 64, n0, F.lane); continue; } r -= I_IN;
        if (r < I_OUT) { const int nb = DM / 32, kb = r / nb, n0 = (r % nb) * 32; p0_transpose_item(F.w_out, DM, DM, F.Wt_out, n0, scr, kb * 64, n0, F.lane); continue; } r -= I_OUT;
        if (r < I_G) { const int nb = DFF / 32, kb = r / nb, n0 = (r % nb) * 32; p0_transpose_item(F.w_gate, DM, DFF, F.Wt_gu, (n0 >> 7) * 256 + (n0 & 127), scr, kb * 64, n0, F.lane); continue; } r -= I_G;
        if (r < I_G) { const int nb = DFF / 32, kb = r / nb, n0 = (r % nb) * 32; p0_transpose_item(F.w_up, DM, DFF, F.Wt_gu, (n0 >> 7) * 256 + 128 + (n0 & 127), scr, kb * 64, n0, F.lane); continue; } r -= I_G;
        { const int nb = DM / 32, kb = r / nb, n0 = (r % nb) * 32; p0_transpose_item(F.w_down, DFF, DM, F.Wt_dn, n0, scr, kb * 64, n0, F.lane); }
    }
}
__device__ __forceinline__ void norm_mod_pass(Frame& F, const float* X, const float* nw, int shift_off, int scale_off, bf16* O) {
    const int gw = F.vcu * NWAVES + F.wave, NGW = F.G * NWAVES;
    for (int m = gw; m < M; m += NGW) {
        const int b = m / SEQ;
        const GAS f32x4* xr = (const GAS f32x4*)(X + (size_t)m * DM) + F.lane;
        f32x4 v[8]; float s = 0.f;
#pragma unroll
        for (int j = 0; j < 8; ++j) { v[j] = xr[64 * j]; s += (v[j].x * v[j].x + v[j].y * v[j].y) + (v[j].z * v[j].z + v[j].w * v[j].w); }
        const float rstd = 1.0f / sqrtf(wave_sum(s) * (1.0f / DM) + EPS);
        GAS unsigned long long* o8 = (GAS unsigned long long*)(O + (size_t)m * DM) + F.lane;
#pragma unroll
        for (int j = 0; j < 8; ++j) { const int col = 256 * j + 4 * F.lane;
            const f32x4 w = *(const f32x4*)(nw + col);
            const f32x4 sc = *(const f32x4*)(F.mod + (size_t)b * MODW + scale_off + col) + *(const f32x4*)(F.b_ada + scale_off + col);
            const f32x4 sh = *(const f32x4*)(F.mod + (size_t)b * MODW + shift_off + col) + *(const f32x4*)(F.b_ada + shift_off + col);
            const f32x4 y = v[j] * rstd * w * (sc + 1.0f) + sh;
            o8[64 * j] = (unsigned long long)pk2(y.x, y.y) | ((unsigned long long)pk2(y.z, y.w) << 32); }
    }
}
__device__ __forceinline__ void final_norm_pass(Frame& F) {
    const int gw = F.vcu * NWAVES + F.wave, NGW = F.G * NWAVES;
    for (int m = gw; m < M; m += NGW) {
        GAS f32x4* xr = (GAS f32x4*)(F.out + (size_t)m * DM) + F.lane;
        f32x4 v[8]; float s = 0.f;
#pragma unroll
        for (int j = 0; j < 8; ++j) { v[j] = xr[64 * j]; s += (v[j].x * v[j].x + v[j].y * v[j].y) + (v[j].z * v[j].z + v[j].w * v[j].w); }
        const float rstd = 1.0f / sqrtf(wave_sum(s) * (1.0f / DM) + EPS);
#pragma unroll
        for (int j = 0; j < 8; ++j) { const f32x4 w = *(const f32x4*)(F.final_w + 256 * j + 4 * F.lane); xr[64 * j] = v[j] * rstd * w; }
    }
}
__device__ __forceinline__ void hgrn_naive(Frame& F, int bh) {
    const int b = bh >> 3, h = bh & 7; const int tid = F.tid, e = tid & 127, dq = tid >> 7;
    LAS float* Fb = (LAS float*)(F.lds + RING_OFF); LAS float* Qb = Fb + 4096; LAS float* Ib = Qb + 4096; LAS float* PO = Ib + 4096;
    float s[32];
#pragma unroll
    for (int i = 0; i < 32; ++i) s[i] = 0.f;
    const float l0 = F.lower_bounds[h * HHD + e], l1 = F.lower_bounds[HW + h * HHD + e];
    const float lbv = 1.0f / (1.0f + __expf(l1 - l0));
    const bf16* P = F.PROJ + (size_t)(b * SEQ) * INW;
    for (int blk = 0; blk < SEQ / 32; ++blk) {
        const int t0 = blk * 32;
#pragma unroll
        for (int i = 0; i < 8; ++i) { const int t = dq + 4 * i; const bf16* pr = P + (size_t)(t0 + t) * INW + h * HHD + e;
            const float q = bf2f(pr[COL_HQ]), fl = bf2f(pr[COL_HF]), iv = bf2f(pr[COL_HI]);
            const float f = lbv + (1.0f - lbv) * (1.0f / (1.0f + __expf(-fl)));
            Fb[t * 128 + e] = f; Qb[t * 128 + e] = q; Ib[t * 128 + e] = iv; }
        __syncthreads();
        for (int t = 0; t < 32; ++t) {
            const float iv = Ib[t * 128 + e]; float po = 0.f;
#pragma unroll
            for (int d4 = 0; d4 < 8; ++d4) { const f32x4 f4 = *(const LAS f32x4*)(Fb + t * 128 + dq * 32 + d4 * 4), q4 = *(const LAS f32x4*)(Qb + t * 128 + dq * 32 + d4 * 4);
#pragma unroll
                for (int j = 0; j < 4; ++j) { const float f = f4[j]; s[d4 * 4 + j] = f * s[d4 * 4 + j] + (1.0f - f) * iv; po += s[d4 * 4 + j] * q4[j]; } }
            PO[(t * 4 + dq) * 128 + e] = po;
        }
        __syncthreads();
#pragma unroll
        for (int i = 0; i < 4; ++i) { const int t = F.wave + 8 * i; float o[2];
#pragma unroll
            for (int k = 0; k < 2; ++k) { const int ee = F.lane + 64 * k; o[k] = (PO[(t * 4 + 0) * 128 + ee] + PO[(t * 4 + 1) * 128 + ee]) + (PO[(t * 4 + 2) * 128 + ee] + PO[(t * 4 + 3) * 128 + ee]); }
            const float rstd = 1.0f / sqrtf(wave_sum(o[0] * o[0] + o[1] * o[1]) * (1.0f / HHD) + EPS);
            const size_t row = (size_t)(b * SEQ + t0 + t);
#pragma unroll
            for (int k = 0; k < 2; ++k) { const int ee = F.lane + 64 * k; const float g = bf2f(F.PROJ[row * INW + COL_HG + h * HHD + ee]);
                const float y = o[k] * rstd * F.hgrn_norm_w[h * HHD + ee] * (g * sigmoidf_(g));
                F.MIX[row * DM + h * HHD + ee] = (bf16)f2bf(y); } }
        __syncthreads();
    }
}
__device__ __forceinline__ void attn_naive_unit(Frame& F, int unit) {
    const int kvh = unit & 3, n = (unit >> 2) & 63, b = unit >> 8;
    const int tid = F.tid, i = tid & 127, g = tid >> 7, head = kvh * 4 + g;
    LAS unsigned char* Kl = F.lds + RING_OFF; LAS unsigned char* Vl = Kl + 36864; LAS float* bt = (LAS float*)(Kl + 73728);
    const bf16* P = F.PROJ + (size_t)(b * SEQ) * INW;
#pragma unroll
    for (int c = 0; c < 4; ++c) { const int idx = tid + 512 * c, r = idx >> 3, ch = idx & 7, kpos = 128 * (n - 1) + r;
        v4u kv = {0u, 0u, 0u, 0u}, vv = {0u, 0u, 0u, 0u};
        if (kpos >= 0) { kv = *(const v4u*)(P + (size_t)kpos * INW + COL_AK + kvh * AHD + ch * 8); vv = *(const v4u*)(P + (size_t)kpos * INW + COL_AV + kvh * AHD + ch * 8); }
        *(LAS v4u*)(Kl + r * 144 + ch * 16) = kv; *(LAS v4u*)(Vl + r * 144 + ch * 16) = vv; }
    bt[tid] = F.rel[T5_BUCKET[tid & 127] * AQH + kvh * 4 + (tid >> 7)];
    float qf[64], o[64];
    { const bf16* qp = P + (size_t)(128 * n + i) * INW + COL_AQ + head * AHD;
#pragma unroll
        for (int c = 0; c < 8; ++c) { const v4u w = *(const v4u*)(qp + c * 8);
#pragma unroll
            for (int k = 0; k < 4; ++k) { qf[c * 8 + 2 * k] = 0.125f * __builtin_bit_cast(float, w[k] << 16); qf[c * 8 + 2 * k + 1] = 0.125f * __builtin_bit_cast(float, w[k] & 0xffff0000u); } } }
#pragma unroll
    for (int d = 0; d < 64; ++d) o[d] = 0.f;
    __syncthreads();
    float mx = F.sinks[head], l = 1.0f;
    for (int jj = 0; jj < 128; ++jj) { const int j = i + 1 + jj;
        if (128 * (n - 1) + j >= 0) {
            float dot = 0.f;
#pragma unroll
            for (int c = 0; c < 8; ++c) { const v4u w = *(const LAS v4u*)(Kl + j * 144 + c * 16);
#pragma unroll
                for (int k = 0; k < 4; ++k) { dot += qf[c * 8 + 2 * k] * __builtin_bit_cast(float, w[k] << 16); dot += qf[c * 8 + 2 * k + 1] * __builtin_bit_cast(float, w[k] & 0xffff0000u); } }
            const float sc = dot + bt[g * 128 + (127 - jj)];
            const float mn = fmaxf(mx, sc), a = __expf(mx - mn), p = __expf(sc - mn); l = l * a + p; mx = mn;
#pragma unroll
            for (int c = 0; c < 8; ++c) { const v4u w = *(const LAS v4u*)(Vl + j * 144 + c * 16);
#pragma unroll
                for (int k = 0; k < 4; ++k) { o[c * 8 + 2 * k] = o[c * 8 + 2 * k] * a + p * __builtin_bit_cast(float, w[k] << 16); o[c * 8 + 2 * k + 1] = o[c * 8 + 2 * k + 1] * a + p * __builtin_bit_cast(float, w[k] & 0xffff0000u); } }
        }
    }
    const float inv = 1.0f / l;
    bf16* op = F.MIX + (size_t)(b * SEQ + 128 * n + i) * DM + HW + head * AHD;
#pragma unroll
    for (int c = 0; c < 8; ++c) { v4u w;
#pragma unroll
        for (int k = 0; k < 4; ++k) w[k] = pk2(o[c * 8 + 2 * k] * inv, o[c * 8 + 2 * k + 1] * inv);
        *(v4u*)(op + c * 8) = w; }
    __syncthreads();
}

struct Args { const float* in[16]; float* out; unsigned char* ws; int ph_lo, ph_hi; };
constexpr int N_PHASES = 9;
__global__ void __launch_bounds__(NWAVES * 64, 2) mk_fwd(Args args) {
    extern __shared__ __attribute__((aligned(16))) unsigned char lds[];
    Frame F;
    F.lds = (LAS unsigned char*)lds;
    F.MISC = (volatile LAS unsigned*)(F.lds + MISC_OFF);
    F.tid = threadIdx.x; F.lane = F.tid & 63; F.wave = __builtin_amdgcn_readfirstlane(F.tid >> 6);
    F.G = gridDim.x; { const int bx = blockIdx.x; F.vcu = (F.G % 8 == 0) ? (bx % 8) * (F.G / 8) + bx / 8 : bx; }
    unsigned char* ws = args.ws;
    F.ctl = (gu32*)(ws + WS_CTL);
    F.x = args.in[0]; F.c = args.in[1]; F.w_ada = args.in[2]; F.b_ada = args.in[3]; F.norm1_w = args.in[4]; F.w_in = args.in[5]; F.lower_bounds = args.in[6]; F.hgrn_norm_w = args.in[7];
    F.sinks = args.in[8]; F.rel = args.in[9]; F.w_out = args.in[10]; F.norm2_w = args.in[11]; F.w_gate = args.in[12]; F.w_up = args.in[13]; F.w_down = args.in[14]; F.final_w = args.in[15];
    F.out = args.out; F.mod = (float*)(ws + WS_MOD);
    F.Wt_in = (bf16*)(ws + WS_WIN); F.Wt_out = (bf16*)(ws + WS_WOUT); F.Wt_gu = (bf16*)(ws + WS_WGU); F.Wt_dn = (bf16*)(ws + WS_WDN);
    F.H = (bf16*)(ws + WS_H); F.MIX = (bf16*)(ws + WS_MIX); F.PROJ = (bf16*)(ws + WS_PROJ);
    for (int u = F.tid; u < (LDS_BYTES - LDSCTL_OFF) / 4; u += NWAVES * 64) ((LAS unsigned*)(F.lds + LDSCTL_OFF))[u] = 0u;
    __syncthreads();
    const int lo = args.ph_lo, hi = args.ph_hi;
    const bool fused = (hi - lo) > 1;
    XcdBarrier bar; bar.bar = (unsigned*)(F.ctl + CW_BAR); bar.x = 0; bar.st = nullptr;
    if (fused) bar = xcd_barrier_post((unsigned*)(F.ctl + CW_BAR), F.MISC + 8);
#define IN(k) (lo <= (k) && (k) < hi)
#define SEAM(k) do { if (IN(k) && IN((k) + 1)) xcd_barrier(bar); } while (0)

    if (IN(0)) { p0a_prologue(F); } SEAM(0);
    if (IN(1)) { norm_mod_pass(F, F.x, F.norm1_w, 0, DM, F.H); } SEAM(1);
    if (IN(2)) { pg8::Gemm g{F.H, F.Wt_in, M, INW, DM}; pg8::StaticOrder S; S.init(M, INW, F.G, (int)blockIdx.x);
        pg8::EpiBf16Plain E{F.PROJ, INW};
        pg8::gemm_phase<pg8::EpiBf16Plain, pg8::StaticOrder, true, true>(F.lds + RING_OFF, g, S, E); } SEAM(2);
    if (IN(3)) {
        if (F.vcu < 16) hgrn_naive(F, F.vcu);
        else for (int u = F.vcu - 16; u < BATCH * 64 * AKV; u += F.G - 16) attn_naive_unit(F, u);
    } SEAM(3);
    if (IN(4)) { pg8::Gemm g{F.MIX, F.Wt_out, M, DM, DM}; pg8::StaticOrder S; S.init(M, DM, F.G, (int)blockIdx.x);
        pg8::EpiResGate E{F.x, F.out, DM, F.mod + 2 * DM, F.b_ada + 2 * DM, MODW, SEQ / 256};
        pg8::gemm_phase<pg8::EpiResGate, pg8::StaticOrder, true, true>(F.lds + RING_OFF, g, S, E); } SEAM(4);
    if (IN(5)) { norm_mod_pass(F, F.out, F.norm2_w, 3 * DM, 4 * DM, F.H); } SEAM(5);
    if (IN(6)) { pg8::Gemm g{F.H, F.Wt_gu, M, 2 * DFF, DM}; pg8::StaticOrder S; S.init(M, 2 * DFF, F.G, (int)blockIdx.x);
        pg8::EpiSwiGLU E{F.PROJ, DFF};
        pg8::gemm_phase<pg8::EpiSwiGLU, pg8::StaticOrder, true, true>(F.lds + RING_OFF, g, S, E); } SEAM(6);
    if (IN(7)) { pg8::Gemm g{F.PROJ, F.Wt_dn, M, DM, DFF}; pg8::StaticOrder S; S.init(M, DM, F.G, (int)blockIdx.x);
        pg8::EpiResGate E{F.out, F.out, DM, F.mod + 5 * DM, F.b_ada + 5 * DM, MODW, SEQ / 256};
        pg8::gemm_phase<pg8::EpiResGate, pg8::StaticOrder, true, true>(F.lds + RING_OFF, g, S, E); } SEAM(7);
    if (IN(8)) { final_norm_pass(F); }
#undef IN
#undef SEAM
}

extern "C" void kernel_launch(void* const* d_in, const int* in_sizes, int n_in, void* d_out, int out_size, void* d_ws, size_t ws_size, hipStream_t stream) {
    static int grid = 0;
    if (grid == 0) {
        if (n_in != 16 || in_sizes[0] != M * DM || out_size != M * DM || ws_size < WS_END) { fprintf(stderr, "kernel_launch: unexpected shapes (n_in %d, in0 %d, out %d, ws %zu); nothing launched\n", n_in, n_in > 0 ? in_sizes[0] : -1, out_size, ws_size); grid = -1; return; }
        int dev = 0, cus = 0, per_cu = 0;
        if (hipGetDevice(&dev) != hipSuccess || hipDeviceGetAttribute(&cus, hipDeviceAttributeMultiprocessorCount, dev) != hipSuccess) { fprintf(stderr, "kernel_launch: device query failed\n"); grid = -1; return; }
        if (hipFuncSetAttribute((const void*)mk_fwd, hipFuncAttributeMaxDynamicSharedMemorySize, LDS_BYTES) != hipSuccess) { fprintf(stderr, "kernel_launch: hipFuncSetAttribute failed\n"); grid = -1; return; }
        if (hipOccupancyMaxActiveBlocksPerMultiprocessor(&per_cu, (const void*)mk_fwd, NWAVES * 64, LDS_BYTES) != hipSuccess || per_cu < 1) { fprintf(stderr, "kernel_launch: occupancy query reports %d blocks per CU; nothing launched\n", per_cu); (void)hipGetLastError(); grid = -1; return; }
        grid = cus;
        fprintf(stderr, "kernel_launch: grid %d (cus %d, occupancy %d per CU)\n", grid, cus, per_cu);
    }
    if (grid < 0) return;
    if (hipMemsetAsync((char*)d_ws + WS_CTL, 0, CTL_ZERO_BYTES, stream) != hipSuccess) { fprintf(stderr, "kernel_launch: memset failed\n"); return; }
    Args a{};
    for (int i = 0; i < 16; ++i) a.in[i] = (const float*)d_in[i];
    a.out = (float*)d_out; a.ws = (unsigned char*)d_ws;
#ifndef MK_N_LAUNCHES
#define MK_N_LAUNCHES 1
#endif
    if (MK_N_LAUNCHES == 1) { a.ph_lo = 0; a.ph_hi = N_PHASES; hipLaunchKernelGGL(mk_fwd, dim3(grid), dim3(NWAVES * 64), LDS_BYTES, stream, a); }
    else for (int p = 0; p < N_PHASES; ++p) { a.ph_lo = p; a.ph_hi = p + 1; hipLaunchKernelGGL(mk_fwd, dim3(grid), dim3(NWAVES * 64), LDS_BYTES, stream, a); }
    const hipError_t le = hipPeekAtLastError();
    if (le != hipSuccess) fprintf(stderr, "kernel_launch: launch failed: %s\n", hipGetErrorName(le));
}
```

```cpp
#include <hip/hip_runtime.h>
#include <cstdio>
#include <cstdint>
namespace pg8 {
#define PG8_LAS __attribute__((address_space(3)))
typedef unsigned short bf16_t;
typedef short bf16x8 __attribute__((ext_vector_type(8)));
typedef float f32x4 __attribute__((ext_vector_type(4)));
typedef unsigned u32x4 __attribute__((ext_vector_type(4)));
constexpr int BM = 256, BK = 64, HALF = 128, HTB = HALF * BK * 2  , STAGE_BYTES = 8 * HTB, NXCD = 8, WGM = 8;

__host__ __device__ __forceinline__ int lds_byte(int r, int c) { const int st = (r >> 4) * 2 + (c >> 5), rr = r & 15, cc = c & 31, ob = rr * 64 + cc * 2; return st * 1024 + (ob ^ (((ob >> 9) & 1) << 5)); }
__host__ __device__ __forceinline__ void stage_rc(int b, int& R, int& C) { const int st = b / 1024, sb = b % 1024, swz = sb ^ (((sb >> 9) & 1) << 5); R = (st >> 1) * 16 + swz / 64; C = (st & 1) * 32 + (swz % 64) / 2; }
__host__ __device__ __forceinline__ int perm32(int rho) { const int n = rho >> 4, i = rho & 15; return 8 * (i >> 2) + 4 * n + (i & 3); }

struct Unit { int pm, pn; };
struct Gemm { const bf16_t* A; const bf16_t* Bt; int M, N, K; };

struct StaticOrder {
    int nM, nN, nwg, G, c;
    __host__ __device__ void init(int M, int N, int G_, int c_) { nM = M / BM; nN = N / BM; nwg = nM * nN; G = G_; c = c_; }
    __host__ __device__ bool next(int i, Unit& u) const {
        const long L = (long)i * G + c; if (L >= nwg) return false;
        int wgid = (int)L; { const int q = nwg / NXCD, r = nwg % NXCD, xcd = wgid % NXCD, off = wgid / NXCD; wgid = (xcd < r ? xcd * (q + 1) : r * (q + 1) + (xcd - r) * q) + off; }
        const int nig = WGM * nN, gid = wgid / nig, fm = gid * WGM, gsz = (nM - fm) < WGM ? (nM - fm) : WGM;
        u.pm = fm + ((wgid % nig) % gsz); u.pn = (wgid % nig) / gsz; return true;
    }
    __device__ __forceinline__ void a_ready(const Unit&) const {}
    __device__ __forceinline__ void done(const Unit&) const {}
};


__device__ __forceinline__ unsigned cvt_pk_bf16(float lo, float hi) { unsigned r; asm volatile("v_cvt_pk_bf16_f32 %0, %1, %2" : "=v"(r) : "v"(lo), "v"(hi)); return r; }

struct EpiBf16Plain {
    static constexpr bool PERM = true, AFTER_DRAIN = false;
    bf16_t* O; int ldc;
    __device__ __forceinline__ void operator()(const f32x4 (&acc)[2][2][4][2], const Unit& u, int wr, int wc, int fr, int fq) const {
        const int row0 = u.pm * BM + wr * 64 + fr, col0 = u.pn * BM + wc * 32 + 8 * fq;
#pragma unroll
        for (int ai = 0; ai < 2; ++ai)
#pragma unroll
            for (int m = 0; m < 4; ++m) { bf16_t* rowp = O + (size_t)(row0 + ai * HALF + m * 16) * ldc + col0;
#pragma unroll
                for (int bj = 0; bj < 2; ++bj) { const f32x4 v0 = acc[ai][bj][m][0], v1 = acc[ai][bj][m][1];
                    u32x4 w; w.x = cvt_pk_bf16(v0[0], v0[1]); w.y = cvt_pk_bf16(v0[2], v0[3]); w.z = cvt_pk_bf16(v1[0], v1[1]); w.w = cvt_pk_bf16(v1[2], v1[3]);
                    *(u32x4*)(rowp + bj * HALF) = w; } }
    }
};
struct EpiResGate {
    static constexpr bool PERM = false, AFTER_DRAIN = false;
    const float* base; float* out; int ldc; const float* gacc; const float* gbias; int gstride; int pm_per_batch;
    __device__ __forceinline__ void operator()(const f32x4 (&acc)[2][2][4][2], const Unit& u, int wr, int wc, int fr, int fq) const {
        const int col0 = u.pn * BM + wc * 32 + 4 * fq; const int b = u.pm / pm_per_batch;
        f32x4 gv[2][2];
#pragma unroll
        for (int bj = 0; bj < 2; ++bj)
#pragma unroll
            for (int n = 0; n < 2; ++n) gv[bj][n] = *(const f32x4*)(gacc + (size_t)b * gstride + col0 + bj * HALF + n * 16) + *(const f32x4*)(gbias + col0 + bj * HALF + n * 16);
#pragma unroll
        for (int ai = 0; ai < 2; ++ai)
#pragma unroll
            for (int m = 0; m < 4; ++m) { const size_t off = (size_t)(u.pm * BM + ai * HALF + wr * 64 + m * 16 + fr) * ldc + col0;
#pragma unroll
                for (int bj = 0; bj < 2; ++bj)
#pragma unroll
                    for (int n = 0; n < 2; ++n) { const f32x4 bs = *(const f32x4*)(base + off + bj * HALF + n * 16);
                        *(f32x4*)(out + off + bj * HALF + n * 16) = bs + gv[bj][n] * acc[ai][bj][m][n]; } }
    }
};
struct EpiSwiGLU {
    static constexpr bool PERM = true, AFTER_DRAIN = false;
    bf16_t* O; int ldc;
    __device__ __forceinline__ void operator()(const f32x4 (&acc)[2][2][4][2], const Unit& u, int wr, int wc, int fr, int fq) const {
        const int row0 = u.pm * BM + wr * 64 + fr, col0 = u.pn * HALF + wc * 32 + 8 * fq;
#pragma unroll
        for (int ai = 0; ai < 2; ++ai)
#pragma unroll
            for (int m = 0; m < 4; ++m) { bf16_t* rowp = O + (size_t)(row0 + ai * HALF + m * 16) * ldc + col0;
                float r[8];
#pragma unroll
                for (int n = 0; n < 2; ++n)
#pragma unroll
                    for (int j = 0; j < 4; ++j) { const float g = acc[ai][0][m][n][j], up = acc[ai][1][m][n][j];
                        const float sg = g * __builtin_amdgcn_rcpf(1.0f + __builtin_amdgcn_exp2f(-1.4426950408889634f * g)); r[n * 4 + j] = sg * up; }
                u32x4 w; w.x = cvt_pk_bf16(r[0], r[1]); w.y = cvt_pk_bf16(r[2], r[3]); w.z = cvt_pk_bf16(r[4], r[5]); w.w = cvt_pk_bf16(r[6], r[7]);
                *(u32x4*)(rowp) = w; }
    }
};

template <class Epi, class Sched, bool ALIGN_EPI = false, bool SP2 = false>
__device__ __forceinline__ void gemm_phase(PG8_LAS unsigned char* lds, const Gemm g, const Sched& S, const Epi& E) {
    const int tid = threadIdx.x, wid = __builtin_amdgcn_readfirstlane(tid >> 6), lane = tid & 63, wr = wid >> 2, wc = wid & 3, fr = lane & 15, fq = lane >> 4;
    const int K = g.K, nt = K / BK;
    unsigned voffA[2], voffB[2];
#pragma unroll
    for (int i = 0; i < 2; ++i) { int R, C; stage_rc(tid * 16 + i * 8192, R, C); const int Rb = Epi::PERM ? ((R & ~31) + perm32(R & 31)) : R;
        voffA[i] = (unsigned)(R * K + C) * 2u; voffB[i] = (unsigned)(Rb * K + C) * 2u; }
    const size_t kstep = (size_t)(BK * 2);
    const size_t hstep = (size_t)HALF * K * 2;
    const size_t tstep = 2 * hstep;
    const unsigned ldsw = (unsigned)wid * 1024u;
    const int aoff = lds_byte(wr * 64 + fr, fq * 8), boff = lds_byte(wc * 32 + fr, fq * 8);
#define PG8_SA(b, h) (((b) * 2 + (h)) * HTB)
#define PG8_SB(b, h) ((4 + (b) * 2 + (h)) * HTB)
#define PG8_STAGE(bufoff, gbase, voff) do { _Pragma("unroll") for (int _i = 0; _i < 2; ++_i) \
        __builtin_amdgcn_global_load_lds((const unsigned*)((const char*)(gbase) + (voff)[_i]), (PG8_LAS unsigned*)(lds + (bufoff) + ldsw + _i * 8192), 16, 0, 0); } while (0)
#define PG8_LDA(dst, b, h) do { _Pragma("unroll") for (int m = 0; m < 4; ++m) _Pragma("unroll") for (int k = 0; k < 2; ++k) dst[m][k] = *(const PG8_LAS bf16x8*)(lds + PG8_SA(b, h) + aoff + m * 2048 + k * 1024); } while (0)
#define PG8_LDB(dst, b, h) do { _Pragma("unroll") for (int n = 0; n < 2; ++n) _Pragma("unroll") for (int k = 0; k < 2; ++k) dst[n][k] = *(const PG8_LAS bf16x8*)(lds + PG8_SB(b, h) + boff + n * 2048 + k * 1024); } while (0)
#define PG8_MMA(ai, bj, At, Bt) do { __builtin_amdgcn_s_setprio(1); _Pragma("unroll") for (int m = 0; m < 4; ++m) _Pragma("unroll") for (int n = 0; n < 2; ++n) _Pragma("unroll") for (int k = 0; k < 2; ++k) \
        acc[ai][bj][m][n] = __builtin_amdgcn_mfma_f32_16x16x32_bf16(Bt[n][k], At[m][k], acc[ai][bj][m][n], 0, 0, 0); __builtin_amdgcn_s_setprio(0); } while (0)
#define PG8_WAIT_V(n) asm volatile("s_waitcnt vmcnt(" #n ")" ::: "memory")
#define PG8_WAIT_L(n) asm volatile("s_waitcnt lgkmcnt(" #n ")" ::: "memory")
#define PG8_BAR __builtin_amdgcn_s_barrier()
#define PG8_SCHED __builtin_amdgcn_sched_barrier(0)
    Unit cur, nxt; int ui = 0;
    if (!S.next(0, cur)) return;
    f32x4 acc[2][2][4][2];
#pragma unroll
    for (int a = 0; a < 2; ++a)
#pragma unroll
        for (int b = 0; b < 2; ++b)
#pragma unroll
            for (int m = 0; m < 4; ++m)
#pragma unroll
                for (int n = 0; n < 2; ++n) acc[a][b][m][n] = (f32x4){0.f, 0.f, 0.f, 0.f};
    bf16x8 At[4][2], B0[2][2], B1[2][2];
    const char* cA = (const char*)g.A + (size_t)cur.pm * tstep; const char* cB = (const char*)g.Bt + (size_t)cur.pn * tstep;
    S.a_ready(cur);
    if constexpr (SP2) {
        PG8_STAGE(PG8_SB(0, 0), cB, voffB); PG8_STAGE(PG8_SB(0, 1), cB + hstep, voffB); PG8_STAGE(PG8_SA(0, 0), cA, voffA); PG8_STAGE(PG8_SA(0, 1), cA + hstep, voffA);
        if (wr == 1) PG8_BAR;
        PG8_WAIT_V(2); PG8_BAR;
        PG8_STAGE(PG8_SB(1, 0), cB + kstep, voffB); PG8_STAGE(PG8_SA(1, 0), cA + kstep, voffA); PG8_STAGE(PG8_SB(1, 1), cB + hstep + kstep, voffB);
        PG8_WAIT_V(6); PG8_BAR;
    } else {
        PG8_STAGE(PG8_SB(0, 0), cB, voffB); PG8_STAGE(PG8_SA(0, 0), cA, voffA); PG8_STAGE(PG8_SB(0, 1), cB + hstep, voffB); PG8_STAGE(PG8_SA(0, 1), cA + hstep, voffA);
        if (wr == 1) PG8_BAR;
        PG8_WAIT_V(4); PG8_BAR;
        PG8_STAGE(PG8_SB(1, 0), cB + kstep, voffB); PG8_STAGE(PG8_SA(1, 0), cA + kstep, voffA); PG8_STAGE(PG8_SB(1, 1), cB + hstep + kstep, voffB);
        PG8_WAIT_V(6); PG8_BAR;
    }
    for (;;) {
        const bool has_next = S.next(ui + 1, nxt);
        const char* nA = has_next ? (const char*)g.A + (size_t)nxt.pm * tstep : cA; const char* nB = has_next ? (const char*)g.Bt + (size_t)nxt.pn * tstep : cB;
        for (int t = 0; t < nt; t += 2) {
            const bool last = (t == nt - 2);
            const char* a1 = cA + (size_t)(t + 1) * kstep;
            const char* a2 = last ? nA : cA + (size_t)(t + 2) * kstep; const char* b2 = last ? nB : cB + (size_t)(t + 2) * kstep;
            const char* a3 = a2 + kstep; const char* b3 = b2 + kstep;
            if (last && has_next) S.a_ready(nxt);
            if constexpr (SP2) {
            PG8_LDB(B0, 0, 0); PG8_LDB(B1, 0, 1); PG8_SCHED; PG8_LDA(At, 0, 0); PG8_STAGE(PG8_SA(1, 1), a1 + hstep, voffA);
            PG8_WAIT_V(8); PG8_WAIT_L(0); PG8_BAR; PG8_MMA(0, 0, At, B0); PG8_MMA(0, 1, At, B1); PG8_BAR; PG8_SCHED;
            PG8_LDA(At, 0, 1); PG8_STAGE(PG8_SB(0, 0), b2, voffB); PG8_STAGE(PG8_SB(0, 1), b2 + hstep, voffB); PG8_STAGE(PG8_SA(0, 0), a2, voffA);
            PG8_WAIT_V(8); PG8_WAIT_L(0); PG8_BAR; PG8_MMA(1, 0, At, B0); PG8_MMA(1, 1, At, B1); PG8_BAR; PG8_SCHED;
            PG8_LDB(B0, 1, 0); PG8_LDB(B1, 1, 1); PG8_SCHED; PG8_LDA(At, 1, 0); PG8_STAGE(PG8_SA(0, 1), a2 + hstep, voffA);
            PG8_WAIT_V(8); PG8_WAIT_L(0); PG8_BAR; PG8_MMA(0, 0, At, B0); PG8_MMA(0, 1, At, B1); PG8_BAR; PG8_SCHED;
            PG8_LDA(At, 1, 1); PG8_STAGE(PG8_SB(1, 0), b3, voffB); PG8_STAGE(PG8_SB(1, 1), b3 + hstep, voffB); PG8_STAGE(PG8_SA(1, 0), a3, voffA);
            PG8_WAIT_V(8); PG8_WAIT_L(0); PG8_BAR; PG8_MMA(1, 0, At, B0); PG8_MMA(1, 1, At, B1); PG8_BAR; PG8_SCHED;
            } else {
            PG8_LDB(B0, 0, 0); PG8_SCHED; PG8_LDA(At, 0, 0); PG8_STAGE(PG8_SA(1, 1), a1 + hstep, voffA);
            PG8_WAIT_L(8); PG8_BAR; PG8_WAIT_L(0); PG8_MMA(0, 0, At, B0); PG8_BAR; PG8_SCHED;
            PG8_LDB(B1, 0, 1); PG8_STAGE(PG8_SB(0, 0), b2, voffB);
            PG8_BAR; PG8_WAIT_L(0); PG8_MMA(0, 1, At, B1); PG8_BAR;
            PG8_LDA(At, 0, 1); PG8_STAGE(PG8_SA(0, 0), a2, voffA);
            PG8_BAR; PG8_WAIT_L(0); PG8_MMA(1, 0, At, B0); PG8_BAR; PG8_SCHED;
            PG8_STAGE(PG8_SB(0, 1), b2 + hstep, voffB);
            PG8_WAIT_V(6); PG8_BAR; PG8_MMA(1, 1, At, B1); PG8_BAR;
            PG8_LDB(B0, 1, 0); PG8_SCHED; PG8_LDA(At, 1, 0); PG8_STAGE(PG8_SA(0, 1), a2 + hstep, voffA);
            PG8_WAIT_L(8); PG8_BAR; PG8_WAIT_L(0); PG8_MMA(0, 0, At, B0); PG8_BAR; PG8_SCHED;
            PG8_LDB(B1, 1, 1); PG8_STAGE(PG8_SB(1, 0), b3, voffB);
            PG8_BAR; PG8_WAIT_L(0); PG8_MMA(0, 1, At, B1); PG8_BAR;
            PG8_LDA(At, 1, 1); PG8_STAGE(PG8_SA(1, 0), a3, voffA);
            PG8_BAR; PG8_WAIT_L(0); PG8_MMA(1, 0, At, B0); PG8_BAR; PG8_SCHED;
            PG8_STAGE(PG8_SB(1, 1), b3 + hstep, voffB);
            PG8_WAIT_V(6); PG8_BAR; PG8_MMA(1, 1, At, B1); PG8_BAR;
            }
        }
        if constexpr (ALIGN_EPI) { if (wr == 0) PG8_BAR; }
        if constexpr (!Epi::AFTER_DRAIN) { E(acc, cur, wr, wc, fr, fq); S.done(cur); }
        if (!has_next) break;
#pragma unroll
        for (int a = 0; a < 2; ++a)
#pragma unroll
            for (int b = 0; b < 2; ++b)
#pragma unroll
                for (int m = 0; m < 4; ++m)
#pragma unroll
                    for (int n = 0; n < 2; ++n) acc[a][b][m][n] = (f32x4){0.f, 0.f, 0.f, 0.f};
        cur = nxt; cA = nA; cB = nB; ++ui;
        if constexpr (ALIGN_EPI) { if (wr == 1) PG8_BAR; }
    }
    PG8_WAIT_V(0);
    if constexpr (!ALIGN_EPI) { if (wr == 0) PG8_BAR; }
    PG8_BAR;
    if constexpr (Epi::AFTER_DRAIN) { E.fused(acc, cur, wr, wc, fr, fq, lds, wid, lane); S.done(cur); }
#undef PG8_SA
#undef PG8_SB
#undef PG8_STAGE
#undef PG8_LDA
#undef PG8_LDB
#undef PG8_MMA
#undef PG8_WAIT_V
#undef PG8_WAIT_L
#undef PG8_BAR
#undef PG8_SCHED
}
}
#define GAS __attribute__((address_space(1)))
#define LAS __attribute__((address_space(3)))
typedef unsigned short bf16;
typedef unsigned v4u __attribute__((ext_vector_type(4)));
typedef float f32x4 __attribute__((ext_vector_type(4)));
typedef short bf16x8 __attribute__((ext_vector_type(8)));
typedef GAS unsigned gu32;
typedef GAS unsigned long long gu64;
#define RLX_AGENT __ATOMIC_RELAXED, __HIP_MEMORY_SCOPE_AGENT
#define LDS_WAIT() asm volatile("s_waitcnt lgkmcnt(0)" ::: "memory")
#define VM_WAIT() asm volatile("s_waitcnt vmcnt(0)" ::: "memory")
__device__ __forceinline__ unsigned long long rt() { return __builtin_amdgcn_s_memrealtime(); }
__device__ __forceinline__ unsigned f2bf(float f) { unsigned u = __builtin_bit_cast(unsigned, f); return (u + 0x7fffu + ((u >> 16) & 1u)) >> 16; }
__device__ __forceinline__ unsigned pk2(float lo, float hi) { return f2bf(lo) | (f2bf(hi) << 16); }

#define XB_TMO      128
#define XB_XCNT(j)  (256  + 64 * (j))
#define XB_XSUB(j)  (1280 + 64 * (j))
#define XB_XGEN(j)  (2304 + 64 * (j))
#define XB_TOP      3328
#define XB_TOPGEN   3392
#define XCD_BAR_WORDS 3456
#define XB_SPIN_CAP (1u << 18)

__device__ __forceinline__ unsigned xb_ld(unsigned* p)              { return __hip_atomic_load(p, __ATOMIC_RELAXED, __HIP_MEMORY_SCOPE_AGENT); }
__device__ __forceinline__ unsigned xb_add(unsigned* p, unsigned v) { return __hip_atomic_fetch_add(p, v, __ATOMIC_RELAXED, __HIP_MEMORY_SCOPE_AGENT); }
__device__ __forceinline__ unsigned xb_xcc_id() { return (unsigned)__builtin_amdgcn_s_getreg((3 << 11) | 20) & 0xFu; }
#define XB_SPIN(cond, bar) do { unsigned _sp = 0; while (cond) { __builtin_amdgcn_s_sleep(1); \
    if ((++_sp & 255u) == 0u) { if (xb_ld(&(bar)[XB_TMO])) break; if (_sp > XB_SPIN_CAP) { atomicAdd(&(bar)[XB_TMO], 1u); break; } } } } while (0)

struct XcdBarrier {
    unsigned* bar; unsigned x;
    volatile LAS unsigned* st;
};

__device__ __forceinline__ XcdBarrier xcd_barrier_post(unsigned* bar, volatile LAS unsigned* st) {
    XcdBarrier b; b.bar = bar; b.x = xb_xcc_id(); b.st = st;
    if (threadIdx.x == 0) (void)xb_add(&bar[XB_XCNT(b.x)], 1u);
    return b;
}
__device__ __forceinline__ void xcd_barrier_complete(unsigned* bar, unsigned x, unsigned& nloc, unsigned& nx) {
    const unsigned G = gridDim.x * gridDim.y * gridDim.z;
    unsigned sum, cnt, mine, sp = 0u;
    for (;;) {
        sum = 0u; cnt = 0u; mine = 0u;
#pragma unroll
        for (unsigned j = 0; j < 16; ++j) { const unsigned c = xb_ld(&bar[XB_XCNT(j)]); sum += c; cnt += (c > 0u) ? 1u : 0u; mine = (j == x) ? c : mine; }
        if (sum == G) break;
        __builtin_amdgcn_s_sleep(1);
        if ((++sp & 255u) == 0u) { if (xb_ld(&bar[XB_TMO])) break; if (sp > XB_SPIN_CAP) { atomicAdd(&bar[XB_TMO], 1u); break; } }
    }
    nloc = mine > 0u ? mine : 1u; nx = cnt > 0u ? cnt : 1u;
}

__device__ __forceinline__ void xcd_barrier(const XcdBarrier& b) {
    asm volatile("s_waitcnt vmcnt(0)" ::: "memory");
    __syncthreads();
    if (threadIdx.x == 0) {
        unsigned* bar = b.bar;
        __builtin_amdgcn_s_waitcnt(0);
        unsigned nloc = b.st[0], nx = b.st[1];
        if (nloc == 0u) { xcd_barrier_complete(bar, b.x, nloc, nx); b.st[0] = nloc; b.st[1] = nx; }
        const unsigned old = xb_add(&bar[XB_XSUB(b.x)], 1u);
        const unsigned gen = old / nloc;
        if (old + 1u == (gen + 1u) * nloc) {
            __builtin_amdgcn_fence(__ATOMIC_RELEASE, "agent");
            asm volatile("s_waitcnt vmcnt(0)" ::: "memory");
            const unsigned og = xb_add(&bar[XB_TOP], 1u);
            const unsigned tg = og / nx;
            if (og + 1u == (tg + 1u) * nx) xb_add(&bar[XB_TOPGEN], 1u);
            else XB_SPIN(xb_ld(&bar[XB_TOPGEN]) == tg, bar);
            __builtin_amdgcn_fence(__ATOMIC_ACQUIRE, "agent");
            xb_add(&bar[XB_XGEN(b.x)], 1u);
            asm volatile("s_waitcnt vmcnt(0)" ::: "memory");
        } else {
            XB_SPIN(xb_ld(&bar[XB_XGEN(b.x)]) == gen, bar);
            __builtin_amdgcn_fence(__ATOMIC_ACQUIRE, "agent");
            asm volatile("s_waitcnt vmcnt(0)" ::: "memory");
        }
    }
    __syncthreads();
}


constexpr int NWAVES = 8;
constexpr int BATCH = 2, SEQ = 8192, DM = 2048, M = BATCH * SEQ;
constexpr int INW = 5632, DFF = 5632, HW = 1024, NHH = 8, HHD = 128, AQH = 16, AKV = 4, AHD = 64;
constexpr int COL_HQ = 0, COL_HF = 1024, COL_HI = 2048, COL_HG = 3072, COL_AQ = 4096, COL_AK = 5120, COL_AV = 5376;
constexpr int MODW = 6 * DM;
constexpr float EPS = 1e-6f;
constexpr size_t MiB = 1u << 20;
constexpr size_t WS_CTL = 0, CTL_ZERO_BYTES = 1 * MiB;
constexpr size_t WS_MOD = 512 * 1024;
constexpr size_t WS_WIN = 2 * MiB, WS_WOUT = 24 * MiB, WS_WGU = 32 * MiB, WS_WDN = 76 * MiB;
constexpr size_t WS_H = 100 * MiB;
constexpr size_t WS_MIX = 164 * MiB;
constexpr size_t WS_PROJ = 228 * MiB;
constexpr size_t WS_SEND = 404 * MiB, WS_SST = 420 * MiB, WS_DG = 436 * MiB;
constexpr size_t WS_END = 437 * MiB;
constexpr int CW_TMO = 0, CW_CODE = 1, CW_BAR = 4096;
constexpr int RING_OFF = 0, RING_BYTES = 131072;
constexpr int LDSCTL_OFF = RING_BYTES, MISC_OFF = LDSCTL_OFF + 320;
constexpr int LDS_BYTES = 147456;

__device__ const int T5_BUCKET[128] = {0,1,2,3,4,5,6,7,8,9,10,11,12,13,14,15,16,16,16,17,17,18,18,18,19,19,19,20,20,20,20,21,21,21,21,22,22,22,22,22,23,23,23,23,23,23,24,24,24,24,24,24,25,25,25,25,25,25,25,26,26,26,26,26,26,26,26,27,27,27,27,27,27,27,27,27,27,28,28,28,28,28,28,28,28,28,28,29,29,29,29,29,29,29,29,29,29,29,29,30,30,30,30,30,30,30,30,30,30,30,30,30,30,31,31,31,31,31,31,31,31,31,31,31,31,31,31,31};

struct Frame {
    LAS unsigned char* lds;
    volatile LAS unsigned* MISC;
    gu32* ctl;
    int tid, lane, wave, vcu, G;
    const float *x, *c, *w_ada, *b_ada, *norm1_w, *w_in, *lower_bounds, *hgrn_norm_w, *sinks, *rel, *w_out, *norm2_w, *w_gate, *w_up, *w_down, *final_w;
    float* out; float* mod; float *Send, *Sst, *Dg;
    bf16 *Wt_in, *Wt_out, *Wt_gu, *Wt_dn, *H, *MIX, *PROJ;
};
__device__ __forceinline__ float bf2f(bf16 v) { return __builtin_bit_cast(float, (unsigned)v << 16); }
__device__ __forceinline__ float wave_sum(float v) {
#pragma unroll
    for (int o = 1; o < 64; o <<= 1) v += __shfl_xor(v, o);
    return v;
}
__device__ __forceinline__ float sigmoidf_(float v) { return __builtin_amdgcn_rcpf(1.0f + __builtin_amdgcn_exp2f(-1.4426950408889634f * v)); }

__device__ __forceinline__ void p0_transpose_item(const float* W, int K, int N, bf16* WT, int drow, LAS float* scr, int k0, int n0, int lane) {
#pragma unroll 8
    for (int i = 0; i < 32; ++i) { const int kk = 2 * i + (lane >> 5); scr[kk * 33 + (lane & 31)] = W[(size_t)(k0 + kk) * N + n0 + (lane & 31)]; }
    LDS_WAIT(); asm volatile("" ::: "memory");
    const int c = lane & 7;
#pragma unroll
    for (int j = 0; j < 4; ++j) { const int n = (lane >> 3) + 8 * j; const LAS float* s = scr + (8 * c) * 33 + n;
        v4u o; o.x = pk2(s[0 * 33], s[1 * 33]); o.y = pk2(s[2 * 33], s[3 * 33]); o.z = pk2(s[4 * 33], s[5 * 33]); o.w = pk2(s[6 * 33], s[7 * 33]);
        *(GAS v4u*)(WT + (size_t)(drow + n) * K + k0 + 8 * c) = o; }
    LDS_WAIT(); asm volatile("" ::: "memory");
}
__device__ __forceinline__ void p0a_prologue(Frame& F) {
    LAS float* scr = (LAS float*)(F.lds + RING_OFF + F.wave * 16384);
    const int gw = F.vcu * NWAVES + F.wave, NGW = F.G * NWAVES;
    for (int it = gw; it < 48 * 32; it += NGW) {
        const int cg = it % 48, ks = it / 48; const int k0 = ks * 64;
        const float c0 = F.c[k0 + F.lane], c1 = F.c[DM + k0 + F.lane];
        const float s0 = c0 * sigmoidf_(c0), s1 = c1 * sigmoidf_(c1);
        f32x4 a0 = {0.f, 0.f, 0.f, 0.f}, a1 = {0.f, 0.f, 0.f, 0.f};
        const float* wp = F.w_ada + (size_t)k0 * MODW + cg * 256 + 4 * F.lane;
#pragma unroll 8
        for (int kk = 0; kk < 64; ++kk) {
            const f32x4 w = *(const f32x4*)(wp + (size_t)kk * MODW);
            const float t0 = __builtin_bit_cast(float, __builtin_amdgcn_readlane(__builtin_bit_cast(int, s0), kk));
            const float t1 = __builtin_bit_cast(float, __builtin_amdgcn_readlane(__builtin_bit_cast(int, s1), kk));
            a0 += w * t0; a1 += w * t1;
        }
        float* m0 = F.mod + cg * 256 + 4 * F.lane; float* m1 = m0 + MODW;
#pragma unroll
        for (int j = 0; j < 4; ++j) { atomicAdd(m0 + j, a0[j]); atomicAdd(m1 + j, a1[j]); }
    }
    constexpr int I_IN = (DM / 64) * (INW / 32), I_OUT = (DM / 64) * (DM / 32), I_G = (DM / 64) * (DFF / 32), I_DN = (DFF / 64) * (DM / 32);
    constexpr int NITEMS = I_IN + I_OUT + 2 * I_G + I_DN;
    for (int it = gw; it < NITEMS; it += NGW) {
        int r = it;
        if (r < I_IN) { const int nb = INW / 32, kb = r / nb, n0 = (r % nb) * 32; p0_transpose_item(F.w_in, DM, INW, F.Wt_in, n0, scr, kb * 64, n0, F.lane); continue; } r -= I_IN;
        if (r < I_OUT) { const int nb = DM / 32, kb = r / nb, n0 = (r % nb) * 32; p0_transpose_item(F.w_out, DM, DM, F.Wt_out, n0, scr, kb * 64, n0, F.lane); continue; } r -= I_OUT;
        if (r < I_G) { const int nb = DFF / 32, kb = r / nb, n0 = (r % nb) * 32; p0_transpose_item(F.w_gate, DM, DFF, F.Wt_gu, (n0 >> 7) * 256 + (n0 & 127), scr, kb * 64, n0, F.lane); continue; } r -= I_G;
        if (r < I_G) { const int nb = DFF / 32, kb = r / nb, n0 = (r % nb) * 32; p0_transpose_item(F.w_up, DM, DFF, F.Wt_gu, (n0 >> 7) * 256 + 128 + (n0 & 127), scr, kb * 64, n0, F.lane); continue; } r -= I_G;
        { const int nb = DM / 32, kb = r / nb, n0 = (r % nb) * 32; p0_transpose_item(F.w_down, DFF, DM, F.Wt_dn, n0, scr, kb * 64, n0, F.lane); }
    }
}
__device__ __forceinline__ void norm_mod_pass(Frame& F, const float* X, const float* nw, int shift_off, int scale_off, bf16* O) {
    const int gw = F.vcu * NWAVES + F.wave, NGW = F.G * NWAVES;
    for (int m = gw; m < M; m += NGW) {
        const int b = m / SEQ;
        const GAS f32x4* xr = (const GAS f32x4*)(X + (size_t)m * DM) + F.lane;
        f32x4 v[8]; float s = 0.f;
#pragma unroll
        for (int j = 0; j < 8; ++j) { v[j] = xr[64 * j]; s += (v[j].x * v[j].x + v[j].y * v[j].y) + (v[j].z * v[j].z + v[j].w * v[j].w); }
        const float rstd = 1.0f / sqrtf(wave_sum(s) * (1.0f / DM) + EPS);
        GAS unsigned long long* o8 = (GAS unsigned long long*)(O + (size_t)m * DM) + F.lane;
#pragma unroll
        for (int j = 0; j < 8; ++j) { const int col = 256 * j + 4 * F.lane;
            const f32x4 w = *(const f32x4*)(nw + col);
            const f32x4 sc = *(const f32x4*)(F.mod + (size_t)b * MODW + scale_off + col) + *(const f32x4*)(F.b_ada + scale_off + col);
            const f32x4 sh = *(const f32x4*)(F.mod + (size_t)b * MODW + shift_off + col) + *(const f32x4*)(F.b_ada + shift_off + col);
            const f32x4 y = v[j] * rstd * w * (sc + 1.0f) + sh;
            o8[64 * j] = (unsigned long long)pk2(y.x, y.y) | ((unsigned long long)pk2(y.z, y.w) << 32); }
    }
}
__device__ __forceinline__ void final_norm_pass(Frame& F) {
    const int gw = F.vcu * NWAVES + F.wave, NGW = F.G * NWAVES;
    for (int m = gw; m < M; m += NGW) {
        GAS f32x4* xr = (GAS f32x4*)(F.out + (size_t)m * DM) + F.lane;
        f32x4 v[8]; float s = 0.f;
#pragma unroll
        for (int j = 0; j < 8; ++j) { v[j] = xr[64 * j]; s += (v[j].x * v[j].x + v[j].y * v[j].y) + (v[j].z * v[j].z + v[j].w * v[j].w); }
        const float rstd = 1.0f / sqrtf(wave_sum(s) * (1.0f / DM) + EPS);
#pragma unroll
        for (int j = 0; j < 8; ++j) { const f32x4 w = *(const f32x4*)(F.final_w + 256 * j + 4 * F.lane); xr[64 * j] = v[j] * rstd * w; }
    }
}
typedef short v4i16_t __attribute__((ext_vector_type(4)));
typedef float f32x2_t __attribute__((ext_vector_type(2)));
typedef __bf16 bf16x2_t __attribute__((ext_vector_type(2)));
typedef unsigned u32x2_t __attribute__((ext_vector_type(2)));
__device__ __forceinline__ unsigned cvtpk(float lo, float hi) { f32x2_t v = {lo, hi}; bf16x2_t b = __builtin_convertvector(v, bf16x2_t); return __builtin_bit_cast(unsigned, b); }
__device__ __forceinline__ v4i16_t vtr(const LAS unsigned char* p) { return __builtin_amdgcn_ds_read_tr16_b64_v4i16((LAS v4i16_t*)p); }
#define MFMA16(a, b, c) __builtin_amdgcn_mfma_f32_16x16x32_bf16((a), (b), (c), 0, 0, 0)
__device__ __forceinline__ int hpi(int q, int rho) { return 32 * (q >> 1) + 8 * (rho >> 2) + 4 * (q & 1) + (rho & 3); }
__device__ __forceinline__ int swzk(int d) { return ((d >> 1) & 1) | (((d >> 3) & 3) << 1); }
__device__ __forceinline__ int swzv(int s) { return (s & 3) | (((s >> 3) & 1) << 2); }
constexpr int HL_QREL = 0, HL_KREL = 16384, HL_QDEC = 32768, HL_KDT = 49152, HL_V = 65536, HL_A = 81920, HL_PT = 90112, HL_DEC = 94208, HL_SS = 94720;
template <bool FULL> __device__ __forceinline__ void hgrn_group(Frame& F, int unit) {
    const int bh = unit >> 4, grp = unit & 15, b = bh >> 3, h = bh & 7;
    const int lane = F.lane, w = F.wave, g = lane >> 4, l16 = lane & 15, tid = F.tid;
    LAS unsigned char* L = F.lds + RING_OFF;
    const size_t row0 = (size_t)b * SEQ + (size_t)grp * 512;
    const bf16* Pg = F.PROJ + row0 * INW + h * HHD;
    const int d0 = 2 * lane;
    float lb0, lb1;
    { const float a0 = F.lower_bounds[h * HHD + d0], a1 = F.lower_bounds[HW + h * HHD + d0], c0 = F.lower_bounds[h * HHD + d0 + 1], c1 = F.lower_bounds[HW + h * HHD + d0 + 1];
      lb0 = 1.0f / (1.0f + __expf(a1 - a0)); lb1 = 1.0f / (1.0f + __expf(c1 - c0)); }
    f32x4 S[8];
    float* Sg = (FULL ? F.Sst : F.Send) + (size_t)unit * 16384;
#pragma unroll
    for (int q = 0; q < 8; ++q)
#pragma unroll
        for (int i = 0; i < 4; ++i) S[q][i] = FULL ? Sg[hpi(q, 4 * g + i) * 128 + 16 * w + l16] : 0.f;
    f32x4 wn = {0.f, 0.f, 0.f, 0.f};
    if (FULL) wn = *(const f32x4*)(F.hgrn_norm_w + h * HHD + 16 * w + 4 * g);
    float dsum0 = 0.f, dsum1 = 0.f;
    for (int ck = 0; ck < 8; ++ck) {
        const bf16* Pc = Pg + (size_t)(ck * 64) * INW;
        unsigned fv[8], qv[8];
#pragma unroll
        for (int tt = 0; tt < 8; ++tt) { const bf16* pr = Pc + (size_t)(8 * w + tt) * INW + d0; fv[tt] = *(const unsigned*)(pr + COL_HF); qv[tt] = FULL ? *(const unsigned*)(pr + COL_HQ) : 0u; }
        v4u vreg[2];
#pragma unroll
        for (int c = 0; c < 2; ++c) { const int idx = tid + 512 * c, s = idx >> 4, c16 = idx & 15; vreg[c] = *(const v4u*)(Pc + (size_t)s * INW + COL_HI + 8 * c16); }
        u32x2_t gq[4];
#pragma unroll
        for (int ti = 0; ti < 4; ++ti) gq[ti] = FULL ? *(const u32x2_t*)(Pc + (size_t)(16 * ti + l16) * INW + COL_HG + 16 * w + 4 * g) : (u32x2_t){0u, 0u};
        float k0[8], k1[8], c0[8], c1[8]; float r0 = 0.f, r1 = 0.f;
#pragma unroll
        for (int tt = 0; tt < 8; ++tt) { const float fl0 = __builtin_bit_cast(float, fv[tt] << 16), fl1 = __builtin_bit_cast(float, fv[tt] & 0xffff0000u);
            const float f0 = lb0 + (1.0f - lb0) * sigmoidf_(fl0), f1 = lb1 + (1.0f - lb1) * sigmoidf_(fl1);
            k0[tt] = 1.0f - f0; k1[tt] = 1.0f - f1; r0 += __builtin_amdgcn_logf(f0); r1 += __builtin_amdgcn_logf(f1); c0[tt] = r0; c1[tt] = r1; }
        *(LAS f32x2_t*)(L + HL_PT + w * 512 + lane * 8) = (f32x2_t){r0, r1};
#pragma unroll
        for (int c = 0; c < 2; ++c) { const int idx = tid + 512 * c, s = idx >> 4, c16 = idx & 15; *(LAS v4u*)(L + HL_V + s * 256 + (((c16 >> 1) ^ swzv(s)) << 5) + (c16 & 1) * 16) = vreg[c]; }
        __syncthreads();
        float pre0 = 0.f, pre1 = 0.f, mid0 = 0.f, mid1 = 0.f, tot0 = 0.f, tot1 = 0.f;
#pragma unroll
        for (int ww = 0; ww < 8; ++ww) { const f32x2_t p = *(const LAS f32x2_t*)(L + HL_PT + ww * 512 + lane * 8);
            if (ww < w) { pre0 += p.x; pre1 += p.y; } if (ww < 4) { mid0 += p.x; mid1 += p.y; } tot0 += p.x; tot1 += p.y; }
        const float cq0 = __builtin_amdgcn_exp2f(mid0), cq1 = __builtin_amdgcn_exp2f(mid1), ck0 = __builtin_amdgcn_exp2f(tot0 - mid0), ck1 = __builtin_amdgcn_exp2f(tot1 - mid1);
        if (w == 0) { *(LAS f32x2_t*)(L + HL_DEC + lane * 8) = (f32x2_t){__builtin_amdgcn_exp2f(tot0), __builtin_amdgcn_exp2f(tot1)}; dsum0 += tot0; dsum1 += tot1; }
        unsigned kd0p[4], kd1p[4]; float kdp0 = 0.f, kdp1 = 0.f;
#pragma unroll
        for (int tt = 0; tt < 8; ++tt) { const int t = 8 * w + tt; const float b0 = pre0 + c0[tt], b1 = pre1 + c1[tt]; float kd0, kd1;
            if (FULL) { const float bm0 = b0 - mid0, bm1 = b1 - mid1;
                const float q0 = __builtin_bit_cast(float, qv[tt] << 16), q1 = __builtin_bit_cast(float, qv[tt] & 0xffff0000u);
                const float qr0 = q0 * __builtin_amdgcn_exp2f(bm0), qr1 = q1 * __builtin_amdgcn_exp2f(bm1), kr0 = k0[tt] * __builtin_amdgcn_exp2f(-bm0), kr1 = k1[tt] * __builtin_amdgcn_exp2f(-bm1);
                const int byte = t * 256 + (((lane >> 2) ^ (t & 15)) << 4) + (lane & 3) * 4;
                *(LAS unsigned*)(L + HL_QREL + byte) = cvtpk(qr0, qr1); *(LAS unsigned*)(L + HL_KREL + byte) = cvtpk(kr0, kr1); *(LAS unsigned*)(L + HL_QDEC + byte) = cvtpk(qr0 * cq0, qr1 * cq1);
                kd0 = kr0 * ck0; kd1 = kr1 * ck1;
            } else { kd0 = k0[tt] * __builtin_amdgcn_exp2f(tot0 - b0); kd1 = k1[tt] * __builtin_amdgcn_exp2f(tot1 - b1); }
            if (tt & 1) { kd0p[tt >> 1] = cvtpk(kdp0, kd0); kd1p[tt >> 1] = cvtpk(kdp1, kd1); } else { kdp0 = kd0; kdp1 = kd1; } }
        *(LAS v4u*)(L + HL_KDT + d0 * 128 + ((w ^ swzk(d0)) << 4)) = (v4u){kd0p[0], kd0p[1], kd0p[2], kd0p[3]};
        *(LAS v4u*)(L + HL_KDT + (d0 + 1) * 128 + ((w ^ swzk(d0 + 1)) << 4)) = (v4u){kd1p[0], kd1p[1], kd1p[2], kd1p[3]};
        __syncthreads();
        bf16x8 vf[2];
#pragma unroll
        for (int ks = 0; ks < 2; ++ks) { const int qq = l16 >> 2, p = l16 & 3, s0 = 32 * ks + 8 * g + qq, s1 = s0 + 4;
            const v4i16_t lo = vtr(L + HL_V + s0 * 256 + ((w ^ swzv(s0)) << 5) + 8 * p), hi = vtr(L + HL_V + s1 * 256 + ((w ^ swzv(s1)) << 5) + 8 * p);
            vf[ks] = __builtin_shufflevector(lo, hi, 0, 1, 2, 3, 4, 5, 6, 7); }
        f32x4 o[4];
        if (FULL) {
            bf16x8 Sf[4];
#pragma unroll
            for (int p = 0; p < 4; ++p) { const v4u pk = {cvtpk(S[2 * p][0], S[2 * p][1]), cvtpk(S[2 * p][2], S[2 * p][3]), cvtpk(S[2 * p + 1][0], S[2 * p + 1][1]), cvtpk(S[2 * p + 1][2], S[2 * p + 1][3])}; Sf[p] = __builtin_bit_cast(bf16x8, pk); }
#pragma unroll
            for (int ti = 0; ti < 4; ++ti) { o[ti] = (f32x4){0.f, 0.f, 0.f, 0.f};
#pragma unroll
                for (int p = 0; p < 4; ++p) { const bf16x8 bq = *(const LAS bf16x8*)(L + HL_QDEC + (16 * ti + l16) * 256 + (((4 * p + g) ^ l16) << 4)); o[ti] = MFMA16(Sf[p], bq, o[ti]); } }
        }
        f32x4 at[2] = {{0.f, 0.f, 0.f, 0.f}, {0.f, 0.f, 0.f, 0.f}};
        if (FULL) {
#pragma unroll
            for (int u = 0; u < 2; ++u) { const int idx = 2 * w + u, si = idx >> 2, ti = idx & 3;
                if (si <= ti) {
#pragma unroll
                    for (int ks = 0; ks < 4; ++ks) { const bf16x8 ak = *(const LAS bf16x8*)(L + HL_KREL + (16 * si + l16) * 256 + (((4 * ks + g) ^ l16) << 4)), bq = *(const LAS bf16x8*)(L + HL_QREL + (16 * ti + l16) * 256 + (((4 * ks + g) ^ l16) << 4));
                        at[u] = MFMA16(ak, bq, at[u]); } } }
        }
#pragma unroll
        for (int q = 0; q < 8; ++q) { const f32x4 dq = *(const LAS f32x4*)(L + HL_DEC + (32 * (q >> 1) + 8 * g + 4 * (q & 1)) * 4); S[q] = S[q] * dq; }
#pragma unroll
        for (int q = 0; q < 8; ++q)
#pragma unroll
            for (int ks = 0; ks < 2; ++ks) { const int d = hpi(q, l16); const bf16x8 ak = *(const LAS bf16x8*)(L + HL_KDT + d * 128 + (((4 * ks + g) ^ swzk(d)) << 4)); S[q] = MFMA16(ak, vf[ks], S[q]); }
        if (FULL) {
            __builtin_amdgcn_sched_barrier(0);
#pragma unroll
            for (int u = 0; u < 2; ++u) { const int idx = 2 * w + u, si = idx >> 2, ti = idx & 3; const bool diag = (si == ti);
                f32x4 acc = at[u];
#pragma unroll
                for (int i = 0; i < 4; ++i) acc[i] = (diag && (4 * g + i > l16)) ? 0.f : acc[i];
                const int t = 16 * ti + l16, s0 = 16 * si + 4 * g;
                *(LAS u32x2_t*)(L + HL_A + t * 128 + (((s0 >> 3) ^ ((t >> 1) & 7)) << 4) + (s0 & 7) * 2) = (u32x2_t){cvtpk(acc[0], acc[1]), cvtpk(acc[2], acc[3])}; }
        }
        if (FULL) {
            __syncthreads();
#pragma unroll
            for (int ti = 0; ti < 4; ++ti)
#pragma unroll
                for (int ks = 0; ks < 2; ++ks) if (ks <= (ti >> 1)) { const int t = 16 * ti + l16; const bf16x8 ba = *(const LAS bf16x8*)(L + HL_A + t * 128 + (((4 * ks + g) ^ ((t >> 1) & 7)) << 4)); o[ti] = MFMA16(vf[ks], ba, o[ti]); }
            float ss[4];
#pragma unroll
            for (int ti = 0; ti < 4; ++ti) { float s = (o[ti][0] * o[ti][0] + o[ti][1] * o[ti][1]) + (o[ti][2] * o[ti][2] + o[ti][3] * o[ti][3]); s += __shfl_xor(s, 16); s += __shfl_xor(s, 32); ss[ti] = s; }
            *(LAS float*)(L + HL_SS + (w * 64 + lane) * 4) = (g == 0) ? ss[0] : (g == 1) ? ss[1] : (g == 2) ? ss[2] : ss[3];
            __syncthreads();
#pragma unroll
            for (int ti = 0; ti < 4; ++ti) { float tot = 0.f;
#pragma unroll
                for (int ww = 0; ww < 8; ++ww) tot += *(const LAS float*)(L + HL_SS + (ww * 64 + 16 * ti + l16) * 4);
                const float rstd = 1.0f / sqrtf(tot * (1.0f / HHD) + EPS);
                const float g0 = __builtin_bit_cast(float, gq[ti].x << 16), g1 = __builtin_bit_cast(float, gq[ti].x & 0xffff0000u), g2 = __builtin_bit_cast(float, gq[ti].y << 16), g3 = __builtin_bit_cast(float, gq[ti].y & 0xffff0000u);
                const float y0 = o[ti][0] * rstd * wn[0] * (g0 * sigmoidf_(g0)), y1 = o[ti][1] * rstd * wn[1] * (g1 * sigmoidf_(g1)), y2 = o[ti][2] * rstd * wn[2] * (g2 * sigmoidf_(g2)), y3 = o[ti][3] * rstd * wn[3] * (g3 * sigmoidf_(g3));
                *(u32x2_t*)(F.MIX + (row0 + (size_t)(ck * 64 + 16 * ti + l16)) * DM + h * HHD + 16 * w + 4 * g) = (u32x2_t){cvtpk(y0, y1), cvtpk(y2, y3)}; }
        } else { __syncthreads(); }
    }
    if (!FULL) {
#pragma unroll
        for (int q = 0; q < 8; ++q)
#pragma unroll
            for (int i = 0; i < 4; ++i) Sg[hpi(q, 4 * g + i) * 128 + 16 * w + l16] = S[q][i];
        if (w == 0) { F.Dg[unit * 128 + d0] = dsum0; F.Dg[unit * 128 + d0 + 1] = dsum1; }
    }
}
__device__ __forceinline__ void hgrn_scan(Frame& F) {
    for (int idx = F.vcu * 512 + F.tid; idx < 16 * 8192; idx += F.G * 512) { const int bh = idx >> 13, rem = idx & 8191, d = rem >> 6, e2 = rem & 63;
        f32x2_t S = {0.f, 0.f};
        for (int gI = 0; gI < 16; ++gI) { const int unit = bh * 16 + gI; const size_t off = (size_t)unit * 16384 + d * 128 + 2 * e2;
            *(f32x2_t*)(F.Sst + off) = S; const float dec = __builtin_amdgcn_exp2f(F.Dg[unit * 128 + d]); const f32x2_t nv = *(const f32x2_t*)(F.Send + off); S = S * dec + nv; } }
}
__device__ __forceinline__ void attn_naive_unit(Frame& F, int unit) {
    const int kvh = unit & 3, n = (unit >> 2) & 63, b = unit >> 8;
    const int tid = F.tid, i = tid & 127, g = tid >> 7, head = kvh * 4 + g;
    LAS unsigned char* Kl = F.lds + RING_OFF; LAS unsigned char* Vl = Kl + 36864; LAS float* bt = (LAS float*)(Kl + 73728);
    const bf16* P = F.PROJ + (size_t)(b * SEQ) * INW;
#pragma unroll
    for (int c = 0; c < 4; ++c) { const int idx = tid + 512 * c, r = idx >> 3, ch = idx & 7, kpos = 128 * (n - 1) + r;
        v4u kv = {0u, 0u, 0u, 0u}, vv = {0u, 0u, 0u, 0u};
        if (kpos >= 0) { kv = *(const v4u*)(P + (size_t)kpos * INW + COL_AK + kvh * AHD + ch * 8); vv = *(const v4u*)(P + (size_t)kpos * INW + COL_AV + kvh * AHD + ch * 8); }
        *(LAS v4u*)(Kl + r * 144 + ch * 16) = kv; *(LAS v4u*)(Vl + r * 144 + ch * 16) = vv; }
    bt[tid] = F.rel[T5_BUCKET[tid & 127] * AQH + kvh * 4 + (tid >> 7)];
    float qf[64], o[64];
    { const bf16* qp = P + (size_t)(128 * n + i) * INW + COL_AQ + head * AHD;
#pragma unroll
        for (int c = 0; c < 8; ++c) { const v4u w = *(const v4u*)(qp + c * 8);
#pragma unroll
            for (int k = 0; k < 4; ++k) { qf[c * 8 + 2 * k] = 0.125f * __builtin_bit_cast(float, w[k] << 16); qf[c * 8 + 2 * k + 1] = 0.125f * __builtin_bit_cast(float, w[k] & 0xffff0000u); } } }
#pragma unroll
    for (int d = 0; d < 64; ++d) o[d] = 0.f;
    __syncthreads();
    float mx = F.sinks[head], l = 1.0f;
    for (int jj = 0; jj < 128; ++jj) { const int j = i + 1 + jj;
        if (128 * (n - 1) + j >= 0) {
            float dot = 0.f;
#pragma unroll
            for (int c = 0; c < 8; ++c) { const v4u w = *(const LAS v4u*)(Kl + j * 144 + c * 16);
#pragma unroll
                for (int k = 0; k < 4; ++k) { dot += qf[c * 8 + 2 * k] * __builtin_bit_cast(float, w[k] << 16); dot += qf[c * 8 + 2 * k + 1] * __builtin_bit_cast(float, w[k] & 0xffff0000u); } }
            const float sc = dot + bt[g * 128 + (127 - jj)];
            const float mn = fmaxf(mx, sc), a = __expf(mx - mn), p = __expf(sc - mn); l = l * a + p; mx = mn;
#pragma unroll
            for (int c = 0; c < 8; ++c) { const v4u w = *(const LAS v4u*)(Vl + j * 144 + c * 16);
#pragma unroll
                for (int k = 0; k < 4; ++k) { o[c * 8 + 2 * k] = o[c * 8 + 2 * k] * a + p * __builtin_bit_cast(float, w[k] << 16); o[c * 8 + 2 * k + 1] = o[c * 8 + 2 * k + 1] * a + p * __builtin_bit_cast(float, w[k] & 0xffff0000u); } }
        }
    }
    const float inv = 1.0f / l;
    bf16* op = F.MIX + (size_t)(b * SEQ + 128 * n + i) * DM + HW + head * AHD;
#pragma unroll
    for (int c = 0; c < 8; ++c) { v4u w;
#pragma unroll
        for (int k = 0; k < 4; ++k) w[k] = pk2(o[c * 8 + 2 * k] * inv, o[c * 8 + 2 * k + 1] * inv);
        *(v4u*)(op + c * 8) = w; }
    __syncthreads();
}

struct Args { const float* in[16]; float* out; unsigned char* ws; int ph_lo, ph_hi; };
constexpr int N_PHASES = 11;
__global__ void __launch_bounds__(NWAVES * 64, 2) mk_fwd(Args args) {
    extern __shared__ __attribute__((aligned(16))) unsigned char lds[];
    Frame F;
    F.lds = (LAS unsigned char*)lds;
    F.MISC = (volatile LAS unsigned*)(F.lds + MISC_OFF);
    F.tid = threadIdx.x; F.lane = F.tid & 63; F.wave = __builtin_amdgcn_readfirstlane(F.tid >> 6);
    F.G = gridDim.x; { const int bx = blockIdx.x; F.vcu = (F.G % 8 == 0) ? (bx % 8) * (F.G / 8) + bx / 8 : bx; }
    unsigned char* ws = args.ws;
    F.ctl = (gu32*)(ws + WS_CTL);
    F.x = args.in[0]; F.c = args.in[1]; F.w_ada = args.in[2]; F.b_ada = args.in[3]; F.norm1_w = args.in[4]; F.w_in = args.in[5]; F.lower_bounds = args.in[6]; F.hgrn_norm_w = args.in[7];
    F.sinks = args.in[8]; F.rel = args.in[9]; F.w_out = args.in[10]; F.norm2_w = args.in[11]; F.w_gate = args.in[12]; F.w_up = args.in[13]; F.w_down = args.in[14]; F.final_w = args.in[15];
    F.out = args.out; F.mod = (float*)(ws + WS_MOD);
    F.Wt_in = (bf16*)(ws + WS_WIN); F.Wt_out = (bf16*)(ws + WS_WOUT); F.Wt_gu = (bf16*)(ws + WS_WGU); F.Wt_dn = (bf16*)(ws + WS_WDN);
    F.Send = (float*)(ws + WS_SEND); F.Sst = (float*)(ws + WS_SST); F.Dg = (float*)(ws + WS_DG);
    F.H = (bf16*)(ws + WS_H); F.MIX = (bf16*)(ws + WS_MIX); F.PROJ = (bf16*)(ws + WS_PROJ);
    for (int u = F.tid; u < (LDS_BYTES - LDSCTL_OFF) / 4; u += NWAVES * 64) ((LAS unsigned*)(F.lds + LDSCTL_OFF))[u] = 0u;
    __syncthreads();
    const int lo = args.ph_lo, hi = args.ph_hi;
    const bool fused = (hi - lo) > 1;
    XcdBarrier bar; bar.bar = (unsigned*)(F.ctl + CW_BAR); bar.x = 0; bar.st = nullptr;
    if (fused) bar = xcd_barrier_post((unsigned*)(F.ctl + CW_BAR), F.MISC + 8);
#define IN(k) (lo <= (k) && (k) < hi)
#define SEAM(k) do { if (IN(k) && IN((k) + 1)) xcd_barrier(bar); } while (0)

    if (IN(0)) { p0a_prologue(F); } SEAM(0);
    if (IN(1)) { norm_mod_pass(F, F.x, F.norm1_w, 0, DM, F.H); } SEAM(1);
    if (IN(2)) { pg8::Gemm g{F.H, F.Wt_in, M, INW, DM}; pg8::StaticOrder S; S.init(M, INW, F.G, (int)blockIdx.x);
        pg8::EpiBf16Plain E{F.PROJ, INW};
        pg8::gemm_phase<pg8::EpiBf16Plain, pg8::StaticOrder, true, true>(F.lds + RING_OFF, g, S, E); } SEAM(2);
    if (IN(3)) { for (int u = F.vcu; u < 256; u += F.G) hgrn_group<false>(F, u); } SEAM(3);
    if (IN(4)) { hgrn_scan(F); for (int u = F.vcu; u < BATCH * 64 * AKV; u += F.G) attn_naive_unit(F, u); } SEAM(4);
    if (IN(5)) { for (int u = F.vcu; u < 256; u += F.G) hgrn_group<true>(F, u); } SEAM(5);
    if (IN(6)) { pg8::Gemm g{F.MIX, F.Wt_out, M, DM, DM}; pg8::StaticOrder S; S.init(M, DM, F.G, (int)blockIdx.x);
        pg8::EpiResGate E{F.x, F.out, DM, F.mod + 2 * DM, F.b_ada + 2 * DM, MODW, SEQ / 256};
        pg8::gemm_phase<pg8::EpiResGate, pg8::StaticOrder, true, true>(F.lds + RING_OFF, g, S, E); } SEAM(6);
    if (IN(7)) { norm_mod_pass(F, F.out, F.norm2_w, 3 * DM, 4 * DM, F.H); } SEAM(7);
    if (IN(8)) { pg8::Gemm g{F.H, F.Wt_gu, M, 2 * DFF, DM}; pg8::StaticOrder S; S.init(M, 2 * DFF, F.G, (int)blockIdx.x);
        pg8::EpiSwiGLU E{F.PROJ, DFF};
        pg8::gemm_phase<pg8::EpiSwiGLU, pg8::StaticOrder, true, true>(F.lds + RING_OFF, g, S, E); } SEAM(8);
    if (IN(9)) { pg8::Gemm g{F.PROJ, F.Wt_dn, M, DM, DFF}; pg8::StaticOrder S; S.init(M, DM, F.G, (int)blockIdx.x);
        pg8::EpiResGate E{F.out, F.out, DM, F.mod + 5 * DM, F.b_ada + 5 * DM, MODW, SEQ / 256};
        pg8::gemm_phase<pg8::EpiResGate, pg8::StaticOrder, true, true>(F.lds + RING_OFF, g, S, E); } SEAM(9);
    if (IN(10)) { final_norm_pass(F); }
#undef IN
#undef SEAM
}

extern "C" void kernel_launch(void* const* d_in, const int* in_sizes, int n_in, void* d_out, int out_size, void* d_ws, size_t ws_size, hipStream_t stream) {
    static int grid = 0;
    if (grid == 0) {
        if (n_in != 16 || in_sizes[0] != M * DM || out_size != M * DM || ws_size < WS_END) { fprintf(stderr, "kernel_launch: unexpected shapes (n_in %d, in0 %d, out %d, ws %zu); nothing launched\n", n_in, n_in > 0 ? in_sizes[0] : -1, out_size, ws_size); grid = -1; return; }
        int dev = 0, cus = 0, per_cu = 0;
        if (hipGetDevice(&dev) != hipSuccess || hipDeviceGetAttribute(&cus, hipDeviceAttributeMultiprocessorCount, dev) != hipSuccess) { fprintf(stderr, "kernel_launch: device query failed\n"); grid = -1; return; }
        if (hipFuncSetAttribute((const void*)mk_fwd, hipFuncAttributeMaxDynamicSharedMemorySize, LDS_BYTES) != hipSuccess) { fprintf(stderr, "kernel_launch: hipFuncSetAttribute failed\n"); grid = -1; return; }
        if (hipOccupancyMaxActiveBlocksPerMultiprocessor(&per_cu, (const void*)mk_fwd, NWAVES * 64, LDS_BYTES) != hipSuccess || per_cu < 1) { fprintf(stderr, "kernel_launch: occupancy query reports %d blocks per CU; nothing launched\n", per_cu); (void)hipGetLastError(); grid = -1; return; }
        grid = cus;
        fprintf(stderr, "kernel_launch: grid %d (cus %d, occupancy %d per CU)\n", grid, cus, per_cu);
    }
    if (grid < 0) return;
    if (hipMemsetAsync((char*)d_ws + WS_CTL, 0, CTL_ZERO_BYTES, stream) != hipSuccess) { fprintf(stderr, "kernel_launch: memset failed\n"); return; }
    Args a{};
    for (int i = 0; i < 16; ++i) a.in[i] = (const float*)d_in[i];
    a.out = (float*)d_out; a.ws = (unsigned char*)d_ws;
#ifndef MK_N_LAUNCHES
#define MK_N_LAUNCHES 1
#endif
    if (MK_N_LAUNCHES == 1) { a.ph_lo = 0; a.ph_hi = N_PHASES; hipLaunchKernelGGL(mk_fwd, dim3(grid), dim3(NWAVES * 64), LDS_BYTES, stream, a); }
    else for (int p = 0; p < N_PHASES; ++p) { a.ph_lo = p; a.ph_hi = p + 1; hipLaunchKernelGGL(mk_fwd, dim3(grid), dim3(NWAVES * 64), LDS_BYTES, stream, a); }
    const hipError_t le = hipPeekAtLastError();
    if (le != hipSuccess) fprintf(stderr, "kernel_launch: launch failed: %s\n", hipGetErrorName(le));
}
```

```cpp
#include <hip/hip_runtime.h>
#include <cstdio>
#include <cstdint>
namespace pg8 {
#define PG8_LAS __attribute__((address_space(3)))
typedef unsigned short bf16_t;
typedef short bf16x8 __attribute__((ext_vector_type(8)));
typedef float f32x4 __attribute__((ext_vector_type(4)));
typedef unsigned u32x4 __attribute__((ext_vector_type(4)));
constexpr int BM = 256, BK = 64, HALF = 128, HTB = HALF * BK * 2  , STAGE_BYTES = 8 * HTB, NXCD = 8, WGM = 8;

__host__ __device__ __forceinline__ int lds_byte(int r, int c) { const int st = (r >> 4) * 2 + (c >> 5), rr = r & 15, cc = c & 31, ob = rr * 64 + cc * 2; return st * 1024 + (ob ^ (((ob >> 9) & 1) << 5)); }
__host__ __device__ __forceinline__ void stage_rc(int b, int& R, int& C) { const int st = b / 1024, sb = b % 1024, swz = sb ^ (((sb >> 9) & 1) << 5); R = (st >> 1) * 16 + swz / 64; C = (st & 1) * 32 + (swz % 64) / 2; }
__host__ __device__ __forceinline__ int perm32(int rho) { const int n = rho >> 4, i = rho & 15; return 8 * (i >> 2) + 4 * n + (i & 3); }

struct Unit { int pm, pn; };
struct Gemm { const bf16_t* A; const bf16_t* Bt; int M, N, K; };

struct StaticOrder {
    int nM, nN, nwg, G, c;
    __host__ __device__ void init(int M, int N, int G_, int c_) { nM = M / BM; nN = N / BM; nwg = nM * nN; G = G_; c = c_; }
    __host__ __device__ bool next(int i, Unit& u) const {
        const long L = (long)i * G + c; if (L >= nwg) return false;
        int wgid = (int)L; { const int q = nwg / NXCD, r = nwg % NXCD, xcd = wgid % NXCD, off = wgid / NXCD; wgid = (xcd < r ? xcd * (q + 1) : r * (q + 1) + (xcd - r) * q) + off; }
        const int nig = WGM * nN, gid = wgid / nig, fm = gid * WGM, gsz = (nM - fm) < WGM ? (nM - fm) : WGM;
        u.pm = fm + ((wgid % nig) % gsz); u.pn = (wgid % nig) / gsz; return true;
    }
    __device__ __forceinline__ void a_ready(const Unit&) const {}
    __device__ __forceinline__ void done(const Unit&) const {}
};


__device__ __forceinline__ unsigned cvt_pk_bf16(float lo, float hi) { unsigned r; asm volatile("v_cvt_pk_bf16_f32 %0, %1, %2" : "=v"(r) : "v"(lo), "v"(hi)); return r; }

struct EpiBf16Plain {
    static constexpr bool PERM = true, AFTER_DRAIN = false;
    bf16_t* O; int ldc;
    __device__ __forceinline__ void operator()(const f32x4 (&acc)[2][2][4][2], const Unit& u, int wr, int wc, int fr, int fq) const {
        const int row0 = u.pm * BM + wr * 64 + fr, col0 = u.pn * BM + wc * 32 + 8 * fq;
#pragma unroll
        for (int ai = 0; ai < 2; ++ai)
#pragma unroll
            for (int m = 0; m < 4; ++m) { bf16_t* rowp = O + (size_t)(row0 + ai * HALF + m * 16) * ldc + col0;
#pragma unroll
                for (int bj = 0; bj < 2; ++bj) { const f32x4 v0 = acc[ai][bj][m][0], v1 = acc[ai][bj][m][1];
                    u32x4 w; w.x = cvt_pk_bf16(v0[0], v0[1]); w.y = cvt_pk_bf16(v0[2], v0[3]); w.z = cvt_pk_bf16(v1[0], v1[1]); w.w = cvt_pk_bf16(v1[2], v1[3]);
                    *(u32x4*)(rowp + bj * HALF) = w; } }
    }
};
struct EpiResGate {
    static constexpr bool PERM = false, AFTER_DRAIN = false;
    const float* base; float* out; int ldc; const float* gacc; const float* gbias; int gstride; int pm_per_batch;
    __device__ __forceinline__ void operator()(const f32x4 (&acc)[2][2][4][2], const Unit& u, int wr, int wc, int fr, int fq) const {
        const int col0 = u.pn * BM + wc * 32 + 4 * fq; const int b = u.pm / pm_per_batch;
        f32x4 gv[2][2];
#pragma unroll
        for (int bj = 0; bj < 2; ++bj)
#pragma unroll
            for (int n = 0; n < 2; ++n) gv[bj][n] = *(const f32x4*)(gacc + (size_t)b * gstride + col0 + bj * HALF + n * 16) + *(const f32x4*)(gbias + col0 + bj * HALF + n * 16);
#pragma unroll
        for (int ai = 0; ai < 2; ++ai)
#pragma unroll
            for (int m = 0; m < 4; ++m) { const size_t off = (size_t)(u.pm * BM + ai * HALF + wr * 64 + m * 16 + fr) * ldc + col0;
#pragma unroll
                for (int bj = 0; bj < 2; ++bj)
#pragma unroll
                    for (int n = 0; n < 2; ++n) { const f32x4 bs = *(const f32x4*)(base + off + bj * HALF + n * 16);
                        *(f32x4*)(out + off + bj * HALF + n * 16) = bs + gv[bj][n] * acc[ai][bj][m][n]; } }
    }
};
struct EpiSwiGLU {
    static constexpr bool PERM = true, AFTER_DRAIN = false;
    bf16_t* O; int ldc;
    __device__ __forceinline__ void operator()(const f32x4 (&acc)[2][2][4][2], const Unit& u, int wr, int wc, int fr, int fq) const {
        const int row0 = u.pm * BM + wr * 64 + fr, col0 = u.pn * HALF + wc * 32 + 8 * fq;
#pragma unroll
        for (int ai = 0; ai < 2; ++ai)
#pragma unroll
            for (int m = 0; m < 4; ++m) { bf16_t* rowp = O + (size_t)(row0 + ai * HALF + m * 16) * ldc + col0;
                float r[8];
#pragma unroll
                for (int n = 0; n < 2; ++n)
#pragma unroll
                    for (int j = 0; j < 4; ++j) { const float g = acc[ai][0][m][n][j], up = acc[ai][1][m][n][j];
                        const float sg = g * __builtin_amdgcn_rcpf(1.0f + __builtin_amdgcn_exp2f(-1.4426950408889634f * g)); r[n * 4 + j] = sg * up; }
                u32x4 w; w.x = cvt_pk_bf16(r[0], r[1]); w.y = cvt_pk_bf16(r[2], r[3]); w.z = cvt_pk_bf16(r[4], r[5]); w.w = cvt_pk_bf16(r[6], r[7]);
                *(u32x4*)(rowp) = w; }
    }
};

template <class Epi, class Sched, bool ALIGN_EPI = false, bool SP2 = false>
__device__ __forceinline__ void gemm_phase(PG8_LAS unsigned char* lds, const Gemm g, const Sched& S, const Epi& E) {
    const int tid = threadIdx.x, wid = __builtin_amdgcn_readfirstlane(tid >> 6), lane = tid & 63, wr = wid >> 2, wc = wid & 3, fr = lane & 15, fq = lane >> 4;
    const int K = g.K, nt = K / BK;
    unsigned voffA[2], voffB[2];
#pragma unroll
    for (int i = 0; i < 2; ++i) { int R, C; stage_rc(tid * 16 + i * 8192, R, C); const int Rb = Epi::PERM ? ((R & ~31) + perm32(R & 31)) : R;
        voffA[i] = (unsigned)(R * K + C) * 2u; voffB[i] = (unsigned)(Rb * K + C) * 2u; }
    const size_t kstep = (size_t)(BK * 2);
    const size_t hstep = (size_t)HALF * K * 2;
    const size_t tstep = 2 * hstep;
    const unsigned ldsw = (unsigned)wid * 1024u;
    const int aoff = lds_byte(wr * 64 + fr, fq * 8), boff = lds_byte(wc * 32 + fr, fq * 8);
#define PG8_SA(b, h) (((b) * 2 + (h)) * HTB)
#define PG8_SB(b, h) ((4 + (b) * 2 + (h)) * HTB)
#define PG8_STAGE(bufoff, gbase, voff) do { _Pragma("unroll") for (int _i = 0; _i < 2; ++_i) \
        __builtin_amdgcn_global_load_lds((const unsigned*)((const char*)(gbase) + (voff)[_i]), (PG8_LAS unsigned*)(lds + (bufoff) + ldsw + _i * 8192), 16, 0, 0); } while (0)
#define PG8_LDA(dst, b, h) do { _Pragma("unroll") for (int m = 0; m < 4; ++m) _Pragma("unroll") for (int k = 0; k < 2; ++k) dst[m][k] = *(const PG8_LAS bf16x8*)(lds + PG8_SA(b, h) + aoff + m * 2048 + k * 1024); } while (0)
#define PG8_LDB(dst, b, h) do { _Pragma("unroll") for (int n = 0; n < 2; ++n) _Pragma("unroll") for (int k = 0; k < 2; ++k) dst[n][k] = *(const PG8_LAS bf16x8*)(lds + PG8_SB(b, h) + boff + n * 2048 + k * 1024); } while (0)
#define PG8_MMA(ai, bj, At, Bt) do { __builtin_amdgcn_s_setprio(1); _Pragma("unroll") for (int m = 0; m < 4; ++m) _Pragma("unroll") for (int n = 0; n < 2; ++n) _Pragma("unroll") for (int k = 0; k < 2; ++k) \
        acc[ai][bj][m][n] = __builtin_amdgcn_mfma_f32_16x16x32_bf16(Bt[n][k], At[m][k], acc[ai][bj][m][n], 0, 0, 0); __builtin_amdgcn_s_setprio(0); } while (0)
#define PG8_WAIT_V(n) asm volatile("s_waitcnt vmcnt(" #n ")" ::: "memory")
#define PG8_WAIT_L(n) asm volatile("s_waitcnt lgkmcnt(" #n ")" ::: "memory")
#define PG8_BAR __builtin_amdgcn_s_barrier()
#define PG8_SCHED __builtin_amdgcn_sched_barrier(0)
    Unit cur, nxt; int ui = 0;
    if (!S.next(0, cur)) return;
    f32x4 acc[2][2][4][2];
#pragma unroll
    for (int a = 0; a < 2; ++a)
#pragma unroll
        for (int b = 0; b < 2; ++b)
#pragma unroll
            for (int m = 0; m < 4; ++m)
#pragma unroll
                for (int n = 0; n < 2; ++n) acc[a][b][m][n] = (f32x4){0.f, 0.f, 0.f, 0.f};
    bf16x8 At[4][2], B0[2][2], B1[2][2];
    const char* cA = (const char*)g.A + (size_t)cur.pm * tstep; const char* cB = (const char*)g.Bt + (size_t)cur.pn * tstep;
    S.a_ready(cur);
    if constexpr (SP2) {
        PG8_STAGE(PG8_SB(0, 0), cB, voffB); PG8_STAGE(PG8_SB(0, 1), cB + hstep, voffB); PG8_STAGE(PG8_SA(0, 0), cA, voffA); PG8_STAGE(PG8_SA(0, 1), cA + hstep, voffA);
        if (wr == 1) PG8_BAR;
        PG8_WAIT_V(2); PG8_BAR;
        PG8_STAGE(PG8_SB(1, 0), cB + kstep, voffB); PG8_STAGE(PG8_SA(1, 0), cA + kstep, voffA); PG8_STAGE(PG8_SB(1, 1), cB + hstep + kstep, voffB);
        PG8_WAIT_V(6); PG8_BAR;
    } else {
        PG8_STAGE(PG8_SB(0, 0), cB, voffB); PG8_STAGE(PG8_SA(0, 0), cA, voffA); PG8_STAGE(PG8_SB(0, 1), cB + hstep, voffB); PG8_STAGE(PG8_SA(0, 1), cA + hstep, voffA);
        if (wr == 1) PG8_BAR;
        PG8_WAIT_V(4); PG8_BAR;
        PG8_STAGE(PG8_SB(1, 0), cB + kstep, voffB); PG8_STAGE(PG8_SA(1, 0), cA + kstep, voffA); PG8_STAGE(PG8_SB(1, 1), cB + hstep + kstep, voffB);
        PG8_WAIT_V(6); PG8_BAR;
    }
    for (;;) {
        const bool has_next = S.next(ui + 1, nxt);
        const char* nA = has_next ? (const char*)g.A + (size_t)nxt.pm * tstep : cA; const char* nB = has_next ? (const char*)g.Bt + (size_t)nxt.pn * tstep : cB;
        for (int t = 0; t < nt; t += 2) {
            const bool last = (t == nt - 2);
            const char* a1 = cA + (size_t)(t + 1) * kstep;
            const char* a2 = last ? nA : cA + (size_t)(t + 2) * kstep; const char* b2 = last ? nB : cB + (size_t)(t + 2) * kstep;
            const char* a3 = a2 + kstep; const char* b3 = b2 + kstep;
            if (last && has_next) S.a_ready(nxt);
            if constexpr (SP2) {
            PG8_LDB(B0, 0, 0); PG8_LDB(B1, 0, 1); PG8_SCHED; PG8_LDA(At, 0, 0); PG8_STAGE(PG8_SA(1, 1), a1 + hstep, voffA);
            PG8_WAIT_V(8); PG8_WAIT_L(0); PG8_BAR; PG8_MMA(0, 0, At, B0); PG8_MMA(0, 1, At, B1); PG8_BAR; PG8_SCHED;
            PG8_LDA(At, 0, 1); PG8_STAGE(PG8_SB(0, 0), b2, voffB); PG8_STAGE(PG8_SB(0, 1), b2 + hstep, voffB); PG8_STAGE(PG8_SA(0, 0), a2, voffA);
            PG8_WAIT_V(8); PG8_WAIT_L(0); PG8_BAR; PG8_MMA(1, 0, At, B0); PG8_MMA(1, 1, At, B1); PG8_BAR; PG8_SCHED;
            PG8_LDB(B0, 1, 0); PG8_LDB(B1, 1, 1); PG8_SCHED; PG8_LDA(At, 1, 0); PG8_STAGE(PG8_SA(0, 1), a2 + hstep, voffA);
            PG8_WAIT_V(8); PG8_WAIT_L(0); PG8_BAR; PG8_MMA(0, 0, At, B0); PG8_MMA(0, 1, At, B1); PG8_BAR; PG8_SCHED;
            PG8_LDA(At, 1, 1); PG8_STAGE(PG8_SB(1, 0), b3, voffB); PG8_STAGE(PG8_SB(1, 1), b3 + hstep, voffB); PG8_STAGE(PG8_SA(1, 0), a3, voffA);
            PG8_WAIT_V(8); PG8_WAIT_L(0); PG8_BAR; PG8_MMA(1, 0, At, B0); PG8_MMA(1, 1, At, B1); PG8_BAR; PG8_SCHED;
            } else {
            PG8_LDB(B0, 0, 0); PG8_SCHED; PG8_LDA(At, 0, 0); PG8_STAGE(PG8_SA(1, 1), a1 + hstep, voffA);
            PG8_WAIT_L(8); PG8_BAR; PG8_WAIT_L(0); PG8_MMA(0, 0, At, B0); PG8_BAR; PG8_SCHED;
            PG8_LDB(B1, 0, 1); PG8_STAGE(PG8_SB(0, 0), b2, voffB);
            PG8_BAR; PG8_WAIT_L(0); PG8_MMA(0, 1, At, B1); PG8_BAR;
            PG8_LDA(At, 0, 1); PG8_STAGE(PG8_SA(0, 0), a2, voffA);
            PG8_BAR; PG8_WAIT_L(0); PG8_MMA(1, 0, At, B0); PG8_BAR; PG8_SCHED;
            PG8_STAGE(PG8_SB(0, 1), b2 + hstep, voffB);
            PG8_WAIT_V(6); PG8_BAR; PG8_MMA(1, 1, At, B1); PG8_BAR;
            PG8_LDB(B0, 1, 0); PG8_SCHED; PG8_LDA(At, 1, 0); PG8_STAGE(PG8_SA(0, 1), a2 + hstep, voffA);
            PG8_WAIT_L(8); PG8_BAR; PG8_WAIT_L(0); PG8_MMA(0, 0, At, B0); PG8_BAR; PG8_SCHED;
            PG8_LDB(B1, 1, 1); PG8_STAGE(PG8_SB(1, 0), b3, voffB);
            PG8_BAR; PG8_WAIT_L(0); PG8_MMA(0, 1, At, B1); PG8_BAR;
            PG8_LDA(At, 1, 1); PG8_STAGE(PG8_SA(1, 0), a3, voffA);
            PG8_BAR; PG8_WAIT_L(0); PG8_MMA(1, 0, At, B0); PG8_BAR; PG8_SCHED;
            PG8_STAGE(PG8_SB(1, 1), b3 + hstep, voffB);
            PG8_WAIT_V(6); PG8_BAR; PG8_MMA(1, 1, At, B1); PG8_BAR;
            }
        }
        if constexpr (ALIGN_EPI) { if (wr == 0) PG8_BAR; }
        if constexpr (!Epi::AFTER_DRAIN) { E(acc, cur, wr, wc, fr, fq); S.done(cur); }
        if (!has_next) break;
#pragma unroll
        for (int a = 0; a < 2; ++a)
#pragma unroll
            for (int b = 0; b < 2; ++b)
#pragma unroll
                for (int m = 0; m < 4; ++m)
#pragma unroll
                    for (int n = 0; n < 2; ++n) acc[a][b][m][n] = (f32x4){0.f, 0.f, 0.f, 0.f};
        cur = nxt; cA = nA; cB = nB; ++ui;
        if constexpr (ALIGN_EPI) { if (wr == 1) PG8_BAR; }
    }
    PG8_WAIT_V(0);
    if constexpr (!ALIGN_EPI) { if (wr == 0) PG8_BAR; }
    PG8_BAR;
    if constexpr (Epi::AFTER_DRAIN) { E.fused(acc, cur, wr, wc, fr, fq, lds, wid, lane); S.done(cur); }
#undef PG8_SA
#undef PG8_SB
#undef PG8_STAGE
#undef PG8_LDA
#undef PG8_LDB
#undef PG8_MMA
#undef PG8_WAIT_V
#undef PG8_WAIT_L
#undef PG8_BAR
#undef PG8_SCHED
}
}
#define GAS __attribute__((address_space(1)))
#define LAS __attribute__((address_space(3)))
typedef unsigned short bf16;
typedef unsigned v4u __attribute__((ext_vector_type(4)));
typedef float f32x4 __attribute__((ext_vector_type(4)));
typedef short bf16x8 __attribute__((ext_vector_type(8)));
typedef GAS unsigned gu32;
typedef GAS unsigned long long gu64;
#define RLX_AGENT __ATOMIC_RELAXED, __HIP_MEMORY_SCOPE_AGENT
#define LDS_WAIT() asm volatile("s_waitcnt lgkmcnt(0)" ::: "memory")
#define VM_WAIT() asm volatile("s_waitcnt vmcnt(0)" ::: "memory")
__device__ __forceinline__ unsigned long long rt() { return __builtin_amdgcn_s_memrealtime(); }
__device__ __forceinline__ unsigned f2bf(float f) { unsigned u = __builtin_bit_cast(unsigned, f); return (u + 0x7fffu + ((u >> 16) & 1u)) >> 16; }
__device__ __forceinline__ unsigned pk2(float lo, float hi) { return f2bf(lo) | (f2bf(hi) << 16); }

#define XB_TMO      128
#define XB_XCNT(j)  (256  + 64 * (j))
#define XB_XSUB(j)  (1280 + 64 * (j))
#define XB_XGEN(j)  (2304 + 64 * (j))
#define XB_TOP      3328
#define XB_TOPGEN   3392
#define XCD_BAR_WORDS 3456
#define XB_SPIN_CAP (1u << 18)

__device__ __forceinline__ unsigned xb_ld(unsigned* p)              { return __hip_atomic_load(p, __ATOMIC_RELAXED, __HIP_MEMORY_SCOPE_AGENT); }
__device__ __forceinline__ unsigned xb_add(unsigned* p, unsigned v) { return __hip_atomic_fetch_add(p, v, __ATOMIC_RELAXED, __HIP_MEMORY_SCOPE_AGENT); }
__device__ __forceinline__ unsigned xb_xcc_id() { return (unsigned)__builtin_amdgcn_s_getreg((3 << 11) | 20) & 0xFu; }
#define XB_SPIN(cond, bar) do { unsigned _sp = 0; while (cond) { __builtin_amdgcn_s_sleep(1); \
    if ((++_sp & 255u) == 0u) { if (xb_ld(&(bar)[XB_TMO])) break; if (_sp > XB_SPIN_CAP) { atomicAdd(&(bar)[XB_TMO], 1u); break; } } } } while (0)

struct XcdBarrier {
    unsigned* bar; unsigned x;
    volatile LAS unsigned* st;
};

__device__ __forceinline__ XcdBarrier xcd_barrier_post(unsigned* bar, volatile LAS unsigned* st) {
    XcdBarrier b; b.bar = bar; b.x = xb_xcc_id(); b.st = st;
    if (threadIdx.x == 0) (void)xb_add(&bar[XB_XCNT(b.x)], 1u);
    return b;
}
__device__ __forceinline__ void xcd_barrier_complete(unsigned* bar, unsigned x, unsigned& nloc, unsigned& nx) {
    const unsigned G = gridDim.x * gridDim.y * gridDim.z;
    unsigned sum, cnt, mine, sp = 0u;
    for (;;) {
        sum = 0u; cnt = 0u; mine = 0u;
#pragma unroll
        for (unsigned j = 0; j < 16; ++j) { const unsigned c = xb_ld(&bar[XB_XCNT(j)]); sum += c; cnt += (c > 0u) ? 1u : 0u; mine = (j == x) ? c : mine; }
        if (sum == G) break;
        __builtin_amdgcn_s_sleep(1);
        if ((++sp & 255u) == 0u) { if (xb_ld(&bar[XB_TMO])) break; if (sp > XB_SPIN_CAP) { atomicAdd(&bar[XB_TMO], 1u); break; } }
    }
    nloc = mine > 0u ? mine : 1u; nx = cnt > 0u ? cnt : 1u;
}

__device__ __forceinline__ void xcd_barrier(const XcdBarrier& b) {
    asm volatile("s_waitcnt vmcnt(0)" ::: "memory");
    __syncthreads();
    if (threadIdx.x == 0) {
        unsigned* bar = b.bar;
        __builtin_amdgcn_s_waitcnt(0);
        unsigned nloc = b.st[0], nx = b.st[1];
        if (nloc == 0u) { xcd_barrier_complete(bar, b.x, nloc, nx); b.st[0] = nloc; b.st[1] = nx; }
        const unsigned old = xb_add(&bar[XB_XSUB(b.x)], 1u);
        const unsigned gen = old / nloc;
        if (old + 1u == (gen + 1u) * nloc) {
            __builtin_amdgcn_fence(__ATOMIC_RELEASE, "agent");
            asm volatile("s_waitcnt vmcnt(0)" ::: "memory");
            const unsigned og = xb_add(&bar[XB_TOP], 1u);
            const unsigned tg = og / nx;
            if (og + 1u == (tg + 1u) * nx) xb_add(&bar[XB_TOPGEN], 1u);
            else XB_SPIN(xb_ld(&bar[XB_TOPGEN]) == tg, bar);
            __builtin_amdgcn_fence(__ATOMIC_ACQUIRE, "agent");
            xb_add(&bar[XB_XGEN(b.x)], 1u);
            asm volatile("s_waitcnt vmcnt(0)" ::: "memory");
        } else {
            XB_SPIN(xb_ld(&bar[XB_XGEN(b.x)]) == gen, bar);
            __builtin_amdgcn_fence(__ATOMIC_ACQUIRE, "agent");
            asm volatile("s_waitcnt vmcnt(0)" ::: "memory");
        }
    }
    __syncthreads();
}


constexpr int NWAVES = 8;
constexpr int BATCH = 2, SEQ = 8192, DM = 2048, M = BATCH * SEQ;
constexpr int INW = 5632, DFF = 5632, HW = 1024, NHH = 8, HHD = 128, AQH = 16, AKV = 4, AHD = 64;
constexpr int COL_HQ = 0, COL_HF = 1024, COL_HI = 2048, COL_HG = 3072, COL_AQ = 4096, COL_AK = 5120, COL_AV = 5376;
constexpr int MODW = 6 * DM;
constexpr float EPS = 1e-6f;
constexpr size_t MiB = 1u << 20;
constexpr size_t WS_CTL = 0, CTL_ZERO_BYTES = 1 * MiB;
constexpr size_t WS_MOD = 512 * 1024;
constexpr size_t WS_WIN = 2 * MiB, WS_WOUT = 24 * MiB, WS_WGU = 32 * MiB, WS_WDN = 76 * MiB;
constexpr size_t WS_H = 100 * MiB;
constexpr size_t WS_MIX = 164 * MiB;
constexpr size_t WS_PROJ = 228 * MiB;
constexpr size_t WS_SEND = 404 * MiB, WS_SST = 420 * MiB, WS_DG = 436 * MiB;
constexpr size_t WS_END = 437 * MiB;
constexpr int CW_TMO = 0, CW_CODE = 1, CW_BAR = 4096;
constexpr int RING_OFF = 0, RING_BYTES = 131072;
constexpr int LDSCTL_OFF = RING_BYTES, MISC_OFF = LDSCTL_OFF + 320;
constexpr int LDS_BYTES = 147456;

__device__ const int T5_BUCKET[128] = {0,1,2,3,4,5,6,7,8,9,10,11,12,13,14,15,16,16,16,17,17,18,18,18,19,19,19,20,20,20,20,21,21,21,21,22,22,22,22,22,23,23,23,23,23,23,24,24,24,24,24,24,25,25,25,25,25,25,25,26,26,26,26,26,26,26,26,27,27,27,27,27,27,27,27,27,27,28,28,28,28,28,28,28,28,28,28,29,29,29,29,29,29,29,29,29,29,29,29,30,30,30,30,30,30,30,30,30,30,30,30,30,30,31,31,31,31,31,31,31,31,31,31,31,31,31,31,31};

struct Frame {
    LAS unsigned char* lds;
    volatile LAS unsigned* MISC;
    gu32* ctl;
    int tid, lane, wave, vcu, G;
    const float *x, *c, *w_ada, *b_ada, *norm1_w, *w_in, *lower_bounds, *hgrn_norm_w, *sinks, *rel, *w_out, *norm2_w, *w_gate, *w_up, *w_down, *final_w;
    float* out; float* mod; float *Send, *Sst, *Dg;
    bf16 *Wt_in, *Wt_out, *Wt_gu, *Wt_dn, *H, *MIX, *PROJ;
};
__device__ __forceinline__ float bf2f(bf16 v) { return __builtin_bit_cast(float, (unsigned)v << 16); }
__device__ __forceinline__ float wave_sum(float v) {
#pragma unroll
    for (int o = 1; o < 64; o <<= 1) v += __shfl_xor(v, o);
    return v;
}
__device__ __forceinline__ float sigmoidf_(float v) { return __builtin_amdgcn_rcpf(1.0f + __builtin_amdgcn_exp2f(-1.4426950408889634f * v)); }

__device__ __forceinline__ void p0_transpose_item(const float* W, int K, int N, bf16* WT, int drow, LAS float* scr, int k0, int n0, int lane) {
#pragma unroll 8
    for (int i = 0; i < 32; ++i) { const int kk = 2 * i + (lane >> 5); scr[kk * 33 + (lane & 31)] = W[(size_t)(k0 + kk) * N + n0 + (lane & 31)]; }
    LDS_WAIT(); asm volatile("" ::: "memory");
    const int c = lane & 7;
#pragma unroll
    for (int j = 0; j < 4; ++j) { const int n = (lane >> 3) + 8 * j; const LAS float* s = scr + (8 * c) * 33 + n;
        v4u o; o.x = pk2(s[0 * 33], s[1 * 33]); o.y = pk2(s[2 * 33], s[3 * 33]); o.z = pk2(s[4 * 33], s[5 * 33]); o.w = pk2(s[6 * 33], s[7 * 33]);
        *(GAS v4u*)(WT + (size_t)(drow + n) * K + k0 + 8 * c) = o; }
    LDS_WAIT(); asm volatile("" ::: "memory");
}
__device__ __forceinline__ void p0a_prologue(Frame& F) {
    LAS float* scr = (LAS float*)(F.lds + RING_OFF + F.wave * 16384);
    const int gw = F.vcu * NWAVES + F.wave, NGW = F.G * NWAVES;
    for (int it = gw; it < 48 * 32; it += NGW) {
        const int cg = it % 48, ks = it / 48; const int k0 = ks * 64;
        const float c0 = F.c[k0 + F.lane], c1 = F.c[DM + k0 + F.lane];
        const float s0 = c0 * sigmoidf_(c0), s1 = c1 * sigmoidf_(c1);
        f32x4 a0 = {0.f, 0.f, 0.f, 0.f}, a1 = {0.f, 0.f, 0.f, 0.f};
        const float* wp = F.w_ada + (size_t)k0 * MODW + cg * 256 + 4 * F.lane;
#pragma unroll 8
        for (int kk = 0; kk < 64; ++kk) {
            const f32x4 w = *(const f32x4*)(wp + (size_t)kk * MODW);
            const float t0 = __builtin_bit_cast(float, __builtin_amdgcn_readlane(__builtin_bit_cast(int, s0), kk));
            const float t1 = __builtin_bit_cast(float, __builtin_amdgcn_readlane(__builtin_bit_cast(int, s1), kk));
            a0 += w * t0; a1 += w * t1;
        }
        float* m0 = F.mod + cg * 256 + 4 * F.lane; float* m1 = m0 + MODW;
#pragma unroll
        for (int j = 0; j < 4; ++j) { atomicAdd(m0 + j, a0[j]); atomicAdd(m1 + j, a1[j]); }
    }
    constexpr int I_IN = (DM / 64) * (INW / 32), I_OUT = (DM / 64) * (DM / 32), I_G = (DM / 64) * (DFF / 32), I_DN = (DFF / 64) * (DM / 32);
    constexpr int NITEMS = I_IN + I_OUT + 2 * I_G + I_DN;
    for (int it = gw; it < NITEMS; it += NGW) {
        int r = it;
        if (r < I_IN) { const int nb = INW / 32, kb = r / nb, n0 = (r % nb) * 32; p0_transpose_item(F.w_in, DM, INW, F.Wt_in, n0, scr, kb * 64, n0, F.lane); continue; } r -= I_IN;
        if (r < I_OUT) { const int nb = DM / 32, kb = r / nb, n0 = (r % nb) * 32; p0_transpose_item(F.w_out, DM, DM, F.Wt_out, n0, scr, kb * 64, n0, F.lane); continue; } r -= I_OUT;
        if (r < I_G) { const int nb = DFF / 32, kb = r / nb, n0 = (r % nb) * 32; p0_transpose_item(F.w_gate, DM, DFF, F.Wt_gu, (n0 >> 7) * 256 + (n0 & 127), scr, kb * 64, n0, F.lane); continue; } r -= I_G;
        if (r < I_G) { const int nb = DFF / 32, kb = r / nb, n0 = (r % nb) * 32; p0_transpose_item(F.w_up, DM, DFF, F.Wt_gu, (n0 >> 7) * 256 + 128 + (n0 & 127), scr, kb * 64, n0, F.lane); continue; } r -= I_G;
        { const int nb = DM / 32, kb = r / nb, n0 = (r % nb) * 32; p0_transpose_item(F.w_down, DFF, DM, F.Wt_dn, n0, scr, kb * 64, n0, F.lane); }
    }
}
__device__ __forceinline__ void norm_mod_pass(Frame& F, const float* X, const float* nw, int shift_off, int scale_off, bf16* O) {
    const int gw = F.vcu * NWAVES + F.wave, NGW = F.G * NWAVES;
    for (int m = gw; m < M; m += NGW) {
        const int b = m / SEQ;
        const GAS f32x4* xr = (const GAS f32x4*)(X + (size_t)m * DM) + F.lane;
        f32x4 v[8]; float s = 0.f;
#pragma unroll
        for (int j = 0; j < 8; ++j) { v[j] = xr[64 * j]; s += (v[j].x * v[j].x + v[j].y * v[j].y) + (v[j].z * v[j].z + v[j].w * v[j].w); }
        const float rstd = 1.0f / sqrtf(wave_sum(s) * (1.0f / DM) + EPS);
        GAS unsigned long long* o8 = (GAS unsigned long long*)(O + (size_t)m * DM) + F.lane;
#pragma unroll
        for (int j = 0; j < 8; ++j) { const int col = 256 * j + 4 * F.lane;
            const f32x4 w = *(const f32x4*)(nw + col);
            const f32x4 sc = *(const f32x4*)(F.mod + (size_t)b * MODW + scale_off + col) + *(const f32x4*)(F.b_ada + scale_off + col);
            const f32x4 sh = *(const f32x4*)(F.mod + (size_t)b * MODW + shift_off + col) + *(const f32x4*)(F.b_ada + shift_off + col);
            const f32x4 y = v[j] * rstd * w * (sc + 1.0f) + sh;
            o8[64 * j] = (unsigned long long)pk2(y.x, y.y) | ((unsigned long long)pk2(y.z, y.w) << 32); }
    }
}
__device__ __forceinline__ void final_norm_pass(Frame& F) {
    const int gw = F.vcu * NWAVES + F.wave, NGW = F.G * NWAVES;
    for (int m = gw; m < M; m += NGW) {
        GAS f32x4* xr = (GAS f32x4*)(F.out + (size_t)m * DM) + F.lane;
        f32x4 v[8]; float s = 0.f;
#pragma unroll
        for (int j = 0; j < 8; ++j) { v[j] = xr[64 * j]; s += (v[j].x * v[j].x + v[j].y * v[j].y) + (v[j].z * v[j].z + v[j].w * v[j].w); }
        const float rstd = 1.0f / sqrtf(wave_sum(s) * (1.0f / DM) + EPS);
#pragma unroll
        for (int j = 0; j < 8; ++j) { const f32x4 w = *(const f32x4*)(F.final_w + 256 * j + 4 * F.lane); xr[64 * j] = v[j] * rstd * w; }
    }
}
typedef short v4i16_t __attribute__((ext_vector_type(4)));
typedef float f32x2_t __attribute__((ext_vector_type(2)));
typedef __bf16 bf16x2_t __attribute__((ext_vector_type(2)));
typedef unsigned u32x2_t __attribute__((ext_vector_type(2)));
__device__ __forceinline__ unsigned cvtpk(float lo, float hi) { f32x2_t v = {lo, hi}; bf16x2_t b = __builtin_convertvector(v, bf16x2_t); return __builtin_bit_cast(unsigned, b); }
__device__ __forceinline__ v4i16_t vtr(const LAS unsigned char* p) { return __builtin_amdgcn_ds_read_tr16_b64_v4i16((LAS v4i16_t*)p); }
#define MFMA16(a, b, c) __builtin_amdgcn_mfma_f32_16x16x32_bf16((a), (b), (c), 0, 0, 0)
__device__ __forceinline__ int hpi(int q, int rho) { return 32 * (q >> 1) + 8 * (rho >> 2) + 4 * (q & 1) + (rho & 3); }
__device__ __forceinline__ int swzk(int d) { return ((d >> 1) & 1) | (((d >> 3) & 3) << 1); }
__device__ __forceinline__ int swzv(int s) { return (s & 3) | (((s >> 3) & 1) << 2); }
constexpr int HL_QREL = 0, HL_KREL = 16384, HL_QDEC = 32768, HL_KDT = 49152, HL_V = 65536, HL_A = 81920, HL_PT = 90112, HL_DEC = 94208, HL_SS = 94720;
template <bool FULL> __device__ __forceinline__ void hgrn_group(Frame& F, int unit) {
    const int bh = unit >> 4, grp = unit & 15, b = bh >> 3, h = bh & 7;
    const int lane = F.lane, w = F.wave, g = lane >> 4, l16 = lane & 15, tid = F.tid;
    LAS unsigned char* L = F.lds + RING_OFF;
    const size_t row0 = (size_t)b * SEQ + (size_t)grp * 512;
    const bf16* Pg = F.PROJ + row0 * INW + h * HHD;
    const int d0 = 2 * lane;
    float lb0, lb1;
    { const float a0 = F.lower_bounds[h * HHD + d0], a1 = F.lower_bounds[HW + h * HHD + d0], c0 = F.lower_bounds[h * HHD + d0 + 1], c1 = F.lower_bounds[HW + h * HHD + d0 + 1];
      lb0 = 1.0f / (1.0f + __expf(a1 - a0)); lb1 = 1.0f / (1.0f + __expf(c1 - c0)); }
    f32x4 S[8];
    float* Sg = (FULL ? F.Sst : F.Send) + (size_t)unit * 16384;
#pragma unroll
    for (int q = 0; q < 8; ++q)
#pragma unroll
        for (int i = 0; i < 4; ++i) S[q][i] = FULL ? Sg[hpi(q, 4 * g + i) * 128 + 16 * w + l16] : 0.f;
    f32x4 wn = {0.f, 0.f, 0.f, 0.f};
    if (FULL) wn = *(const f32x4*)(F.hgrn_norm_w + h * HHD + 16 * w + 4 * g);
    float dsum0 = 0.f, dsum1 = 0.f;
    for (int ck = 0; ck < 8; ++ck) {
        const bf16* Pc = Pg + (size_t)(ck * 64) * INW;
        unsigned fv[8], qv[8];
#pragma unroll
        for (int tt = 0; tt < 8; ++tt) { const bf16* pr = Pc + (size_t)(8 * w + tt) * INW + d0; fv[tt] = *(const unsigned*)(pr + COL_HF); qv[tt] = FULL ? *(const unsigned*)(pr + COL_HQ) : 0u; }
        v4u vreg[2];
#pragma unroll
        for (int c = 0; c < 2; ++c) { const int idx = tid + 512 * c, s = idx >> 4, c16 = idx & 15; vreg[c] = *(const v4u*)(Pc + (size_t)s * INW + COL_HI + 8 * c16); }
        u32x2_t gq[4];
#pragma unroll
        for (int ti = 0; ti < 4; ++ti) gq[ti] = FULL ? *(const u32x2_t*)(Pc + (size_t)(16 * ti + l16) * INW + COL_HG + 16 * w + 4 * g) : (u32x2_t){0u, 0u};
        float k0[8], k1[8], c0[8], c1[8]; float r0 = 0.f, r1 = 0.f;
#pragma unroll
        for (int tt = 0; tt < 8; ++tt) { const float fl0 = __builtin_bit_cast(float, fv[tt] << 16), fl1 = __builtin_bit_cast(float, fv[tt] & 0xffff0000u);
            const float f0 = lb0 + (1.0f - lb0) * sigmoidf_(fl0), f1 = lb1 + (1.0f - lb1) * sigmoidf_(fl1);
            k0[tt] = 1.0f - f0; k1[tt] = 1.0f - f1; r0 += __builtin_amdgcn_logf(f0); r1 += __builtin_amdgcn_logf(f1); c0[tt] = r0; c1[tt] = r1; }
        *(LAS f32x2_t*)(L + HL_PT + w * 512 + lane * 8) = (f32x2_t){r0, r1};
#pragma unroll
        for (int c = 0; c < 2; ++c) { const int idx = tid + 512 * c, s = idx >> 4, c16 = idx & 15; *(LAS v4u*)(L + HL_V + s * 256 + (((c16 >> 1) ^ swzv(s)) << 5) + (c16 & 1) * 16) = vreg[c]; }
        __syncthreads();
        float pre0 = 0.f, pre1 = 0.f, mid0 = 0.f, mid1 = 0.f, tot0 = 0.f, tot1 = 0.f;
#pragma unroll
        for (int ww = 0; ww < 8; ++ww) { const f32x2_t p = *(const LAS f32x2_t*)(L + HL_PT + ww * 512 + lane * 8);
            if (ww < w) { pre0 += p.x; pre1 += p.y; } if (ww < 4) { mid0 += p.x; mid1 += p.y; } tot0 += p.x; tot1 += p.y; }
        const float cq0 = __builtin_amdgcn_exp2f(mid0), cq1 = __builtin_amdgcn_exp2f(mid1), ck0 = __builtin_amdgcn_exp2f(tot0 - mid0), ck1 = __builtin_amdgcn_exp2f(tot1 - mid1);
        if (w == 0) { *(LAS f32x2_t*)(L + HL_DEC + lane * 8) = (f32x2_t){__builtin_amdgcn_exp2f(tot0), __builtin_amdgcn_exp2f(tot1)}; dsum0 += tot0; dsum1 += tot1; }
        unsigned kd0p[4], kd1p[4]; float kdp0 = 0.f, kdp1 = 0.f;
#pragma unroll
        for (int tt = 0; tt < 8; ++tt) { const int t = 8 * w + tt; const float b0 = pre0 + c0[tt], b1 = pre1 + c1[tt]; float kd0, kd1;
            if (FULL) { const float bm0 = b0 - mid0, bm1 = b1 - mid1;
                const float q0 = __builtin_bit_cast(float, qv[tt] << 16), q1 = __builtin_bit_cast(float, qv[tt] & 0xffff0000u);
                const float qr0 = q0 * __builtin_amdgcn_exp2f(bm0), qr1 = q1 * __builtin_amdgcn_exp2f(bm1), kr0 = k0[tt] * __builtin_amdgcn_exp2f(-bm0), kr1 = k1[tt] * __builtin_amdgcn_exp2f(-bm1);
                const int byte = t * 256 + (((lane >> 2) ^ (t & 15)) << 4) + (lane & 3) * 4;
                *(LAS unsigned*)(L + HL_QREL + byte) = cvtpk(qr0, qr1); *(LAS unsigned*)(L + HL_KREL + byte) = cvtpk(kr0, kr1); *(LAS unsigned*)(L + HL_QDEC + byte) = cvtpk(qr0 * cq0, qr1 * cq1);
                kd0 = kr0 * ck0; kd1 = kr1 * ck1;
            } else { kd0 = k0[tt] * __builtin_amdgcn_exp2f(tot0 - b0); kd1 = k1[tt] * __builtin_amdgcn_exp2f(tot1 - b1); }
            if (tt & 1) { kd0p[tt >> 1] = cvtpk(kdp0, kd0); kd1p[tt >> 1] = cvtpk(kdp1, kd1); } else { kdp0 = kd0; kdp1 = kd1; } }
        *(LAS v4u*)(L + HL_KDT + d0 * 128 + ((w ^ swzk(d0)) << 4)) = (v4u){kd0p[0], kd0p[1], kd0p[2], kd0p[3]};
        *(LAS v4u*)(L + HL_KDT + (d0 + 1) * 128 + ((w ^ swzk(d0 + 1)) << 4)) = (v4u){kd1p[0], kd1p[1], kd1p[2], kd1p[3]};
        __syncthreads();
        bf16x8 vf[2];
#pragma unroll
        for (int ks = 0; ks < 2; ++ks) { const int qq = l16 >> 2, p = l16 & 3, s0 = 32 * ks + 8 * g + qq, s1 = s0 + 4;
            const v4i16_t lo = vtr(L + HL_V + s0 * 256 + ((w ^ swzv(s0)) << 5) + 8 * p), hi = vtr(L + HL_V + s1 * 256 + ((w ^ swzv(s1)) << 5) + 8 * p);
            vf[ks] = __builtin_shufflevector(lo, hi, 0, 1, 2, 3, 4, 5, 6, 7); }
        f32x4 o[4];
        if (FULL) {
            bf16x8 Sf[4];
#pragma unroll
            for (int p = 0; p < 4; ++p) { const v4u pk = {cvtpk(S[2 * p][0], S[2 * p][1]), cvtpk(S[2 * p][2], S[2 * p][3]), cvtpk(S[2 * p + 1][0], S[2 * p + 1][1]), cvtpk(S[2 * p + 1][2], S[2 * p + 1][3])}; Sf[p] = __builtin_bit_cast(bf16x8, pk); }
#pragma unroll
            for (int ti = 0; ti < 4; ++ti) { o[ti] = (f32x4){0.f, 0.f, 0.f, 0.f};
#pragma unroll
                for (int p = 0; p < 4; ++p) { const bf16x8 bq = *(const LAS bf16x8*)(L + HL_QDEC + (16 * ti + l16) * 256 + (((4 * p + g) ^ l16) << 4)); o[ti] = MFMA16(Sf[p], bq, o[ti]); } }
        }
        f32x4 at[2] = {{0.f, 0.f, 0.f, 0.f}, {0.f, 0.f, 0.f, 0.f}};
        if (FULL) {
#pragma unroll
            for (int u = 0; u < 2; ++u) { const int idx = 2 * w + u, si = idx >> 2, ti = idx & 3;
                if (si <= ti) {
#pragma unroll
                    for (int ks = 0; ks < 4; ++ks) { const bf16x8 ak = *(const LAS bf16x8*)(L + HL_KREL + (16 * si + l16) * 256 + (((4 * ks + g) ^ l16) << 4)), bq = *(const LAS bf16x8*)(L + HL_QREL + (16 * ti + l16) * 256 + (((4 * ks + g) ^ l16) << 4));
                        at[u] = MFMA16(ak, bq, at[u]); } } }
        }
#pragma unroll
        for (int q = 0; q < 8; ++q) { const f32x4 dq = *(const LAS f32x4*)(L + HL_DEC + (32 * (q >> 1) + 8 * g + 4 * (q & 1)) * 4); S[q] = S[q] * dq; }
#pragma unroll
        for (int q = 0; q < 8; ++q)
#pragma unroll
            for (int ks = 0; ks < 2; ++ks) { const int d = hpi(q, l16); const bf16x8 ak = *(const LAS bf16x8*)(L + HL_KDT + d * 128 + (((4 * ks + g) ^ swzk(d)) << 4)); S[q] = MFMA16(ak, vf[ks], S[q]); }
        if (FULL) {
            __builtin_amdgcn_sched_barrier(0);
#pragma unroll
            for (int u = 0; u < 2; ++u) { const int idx = 2 * w + u, si = idx >> 2, ti = idx & 3; const bool diag = (si == ti);
                f32x4 acc = at[u];
#pragma unroll
                for (int i = 0; i < 4; ++i) acc[i] = (diag && (4 * g + i > l16)) ? 0.f : acc[i];
                const int t = 16 * ti + l16, s0 = 16 * si + 4 * g;
                *(LAS u32x2_t*)(L + HL_A + t * 128 + (((s0 >> 3) ^ ((t >> 1) & 7)) << 4) + (s0 & 7) * 2) = (u32x2_t){cvtpk(acc[0], acc[1]), cvtpk(acc[2], acc[3])}; }
        }
        if (FULL) {
            __syncthreads();
#pragma unroll
            for (int ti = 0; ti < 4; ++ti)
#pragma unroll
                for (int ks = 0; ks < 2; ++ks) if (ks <= (ti >> 1)) { const int t = 16 * ti + l16; const bf16x8 ba = *(const LAS bf16x8*)(L + HL_A + t * 128 + (((4 * ks + g) ^ ((t >> 1) & 7)) << 4)); o[ti] = MFMA16(vf[ks], ba, o[ti]); }
            float ss[4];
#pragma unroll
            for (int ti = 0; ti < 4; ++ti) { float s = (o[ti][0] * o[ti][0] + o[ti][1] * o[ti][1]) + (o[ti][2] * o[ti][2] + o[ti][3] * o[ti][3]); s += __shfl_xor(s, 16); s += __shfl_xor(s, 32); ss[ti] = s; }
            *(LAS float*)(L + HL_SS + (w * 64 + lane) * 4) = (g == 0) ? ss[0] : (g == 1) ? ss[1] : (g == 2) ? ss[2] : ss[3];
            __syncthreads();
#pragma unroll
            for (int ti = 0; ti < 4; ++ti) { float tot = 0.f;
#pragma unroll
                for (int ww = 0; ww < 8; ++ww) tot += *(const LAS float*)(L + HL_SS + (ww * 64 + 16 * ti + l16) * 4);
                const float rstd = 1.0f / sqrtf(tot * (1.0f / HHD) + EPS);
                const float g0 = __builtin_bit_cast(float, gq[ti].x << 16), g1 = __builtin_bit_cast(float, gq[ti].x & 0xffff0000u), g2 = __builtin_bit_cast(float, gq[ti].y << 16), g3 = __builtin_bit_cast(float, gq[ti].y & 0xffff0000u);
                const float y0 = o[ti][0] * rstd * wn[0] * (g0 * sigmoidf_(g0)), y1 = o[ti][1] * rstd * wn[1] * (g1 * sigmoidf_(g1)), y2 = o[ti][2] * rstd * wn[2] * (g2 * sigmoidf_(g2)), y3 = o[ti][3] * rstd * wn[3] * (g3 * sigmoidf_(g3));
                *(u32x2_t*)(F.MIX + (row0 + (size_t)(ck * 64 + 16 * ti + l16)) * DM + h * HHD + 16 * w + 4 * g) = (u32x2_t){cvtpk(y0, y1), cvtpk(y2, y3)}; }
        } else { __syncthreads(); }
    }
    if (!FULL) {
#pragma unroll
        for (int q = 0; q < 8; ++q)
#pragma unroll
            for (int i = 0; i < 4; ++i) Sg[hpi(q, 4 * g + i) * 128 + 16 * w + l16] = S[q][i];
        if (w == 0) { F.Dg[unit * 128 + d0] = dsum0; F.Dg[unit * 128 + d0 + 1] = dsum1; }
    }
}
__device__ __forceinline__ void hgrn_scan(Frame& F) {
    for (int idx = F.vcu * 512 + F.tid; idx < 16 * 8192; idx += F.G * 512) { const int bh = idx >> 13, rem = idx & 8191, d = rem >> 6, e2 = rem & 63;
        f32x2_t S = {0.f, 0.f};
        for (int gI = 0; gI < 16; ++gI) { const int unit = bh * 16 + gI; const size_t off = (size_t)unit * 16384 + d * 128 + 2 * e2;
            *(f32x2_t*)(F.Sst + off) = S; const float dec = __builtin_amdgcn_exp2f(F.Dg[unit * 128 + d]); const f32x2_t nv = *(const f32x2_t*)(F.Send + off); S = S * dec + nv; } }
}
typedef float f32x16 __attribute__((ext_vector_type(16)));
constexpr int AL_K = 0, AL_V = 32768, AL_TAB = 65536, AL_WSF = 71680, AL_OST = 73728;
constexpr float ATT_C2 = 0.125f * 1.4426950408889634f, LOG2E = 1.4426950408889634f, ATT_NEG = -1.0e30f;
__device__ __forceinline__ int crow(int r, int hi) { return (r & 3) + 8 * (r >> 2) + 4 * hi; }
#define MFMA32(a, b, c) __builtin_amdgcn_mfma_f32_32x32x16_bf16((a), (b), (c), 0, 0, 0)
__device__ __forceinline__ void attn_unit(Frame& F, int unit) {
    const int kvh = unit & 3, n = (unit >> 2) & 63, b = unit >> 8;
    const int tid = F.tid, lane = F.lane, w = F.wave, r32 = lane & 31, hi = lane >> 5, qs = w & 3, hp = w >> 2;
    LAS unsigned char* L = F.lds + RING_OFF;
    const bf16* P = F.PROJ + (size_t)(b * SEQ) * INW;
#pragma unroll
    for (int kt = 0; kt < 4; ++kt) { const int row = tid >> 3, c8 = tid & 7, kpos = 128 * (n - 1) + 64 * kt + row;
        v4u kv = {0u, 0u, 0u, 0u}, vv = {0u, 0u, 0u, 0u};
        if (kpos >= 0) { kv = *(const v4u*)(P + (size_t)kpos * INW + COL_AK + kvh * AHD + c8 * 8); vv = *(const v4u*)(P + (size_t)kpos * INW + COL_AV + kvh * AHD + c8 * 8); }
        *(LAS v4u*)(L + AL_K + kt * 8192 + c8 * 1024 + row * 16) = kv;
        *(LAS v4u*)(L + AL_V + kt * 8192 + (c8 >> 2) * 4096 + (row >> 4) * 1024 + (row & 15) * 64 + (c8 & 3) * 16) = vv; }
#pragma unroll
    for (int i = 0; i < 3; ++i) { const int e = tid + 512 * i, hl = e / 384, idx = e - hl * 384, dist = idx - 127;
        float v = ATT_NEG; if (dist >= 0 && dist < 128) v = F.rel[T5_BUCKET[dist] * AQH + kvh * 4 + hl] * LOG2E;
        *(LAS float*)(L + AL_TAB + e * 4) = v; }
    __syncthreads();
    LAS float* wsf = (LAS float*)(L + AL_WSF) + w * 64;
    const int kt0 = qs >> 1;
#pragma unroll 1
    for (int hh = 0; hh < 2; ++hh) {
        const int hl = 2 * hp + hh, head = kvh * 4 + hl;
        bf16x8 qr[4];
        { const bf16* qp = P + (size_t)(128 * n + 32 * qs + r32) * INW + COL_AQ + head * AHD + hi * 8;
#pragma unroll
          for (int d0 = 0; d0 < 4; ++d0) qr[d0] = *(const bf16x8*)(qp + d0 * 16); }
        f32x16 s[3][2];
#pragma unroll
        for (int j = 0; j < 3; ++j) { const LAS unsigned char* kb = L + AL_K + (kt0 + j) * 8192 + hi * 1024 + r32 * 16;
#pragma unroll
            for (int d0 = 0; d0 < 4; ++d0) { const bf16x8 b0 = *(const LAS bf16x8*)(kb + d0 * 2048), b1 = *(const LAS bf16x8*)(kb + d0 * 2048 + 512);
                if (d0 == 0) { f32x16 z;
#pragma unroll
                    for (int r = 0; r < 16; ++r) z[r] = 0.f;
                    s[j][0] = MFMA32(b0, qr[0], z); s[j][1] = MFMA32(b1, qr[0], z); }
                else { s[j][0] = MFMA32(b0, qr[d0], s[j][0]); s[j][1] = MFMA32(b1, qr[d0], s[j][1]); } } }
        const float sink2 = F.sinks[head] * LOG2E;
        float mx = sink2;
#pragma unroll
        for (int j = 0; j < 3; ++j)
#pragma unroll
            for (int hf = 0; hf < 2; ++hf) { const bool dead = (n == 0) && (kt0 + j < 2);
                const int ibase = dead ? 126 : (32 * qs + r32 + 255 - 64 * (kt0 + j) - 4 * hi - 32 * hf);
                const LAS float* tp = (const LAS float*)(L + AL_TAB) + hl * 384 + ibase;
#pragma unroll
                for (int r = 0; r < 16; ++r) { const float v = s[j][hf][r] * ATT_C2 + tp[-((r & 3) + 8 * (r >> 2))]; s[j][hf][r] = v; mx = fmaxf(mx, v); } }
        mx = fmaxf(mx, __shfl_xor(mx, 32));
        float lsum = 0.f;
#pragma unroll
        for (int j = 0; j < 3; ++j)
#pragma unroll
            for (int hf = 0; hf < 2; ++hf)
#pragma unroll
                for (int r = 0; r < 16; ++r) { const float p = __builtin_amdgcn_exp2f(s[j][hf][r] - mx); s[j][hf][r] = p; lsum += p; }
        lsum += __shfl_xor(lsum, 32);
        lsum += __builtin_amdgcn_exp2f(sink2 - mx);
        if (hi == 0) wsf[32 + r32] = lsum;
        f32x16 o[2];
#pragma unroll
        for (int r = 0; r < 16; ++r) { o[0][r] = 0.f; o[1][r] = 0.f; }
#pragma unroll
        for (int j = 0; j < 3; ++j) { const LAS unsigned char* vb = L + AL_V + (kt0 + j) * 8192 + ((lane >> 4) & 1) * 32 + (lane & 3) * 8 + (4 * hi + ((lane & 15) >> 2)) * 64;
            bf16x8 pa[4];
#pragma unroll
            for (int k = 0; k < 4; ++k) { const f32x16& pp = s[j][k >> 1]; const int o8 = (k & 1) * 8;
                const v4u pk = {cvtpk(pp[o8 + 0], pp[o8 + 1]), cvtpk(pp[o8 + 2], pp[o8 + 3]), cvtpk(pp[o8 + 4], pp[o8 + 5]), cvtpk(pp[o8 + 6], pp[o8 + 7])}; pa[k] = __builtin_bit_cast(bf16x8, pk); }
#pragma unroll
            for (int d0 = 0; d0 < 2; ++d0)
#pragma unroll
                for (int ks = 0; ks < 4; ++ks) { const v4i16_t lo = vtr(vb + d0 * 4096 + ks * 1024), hv = vtr(vb + d0 * 4096 + ks * 1024 + 512);
                    const bf16x8 vfr = __builtin_shufflevector(lo, hv, 0, 1, 2, 3, 4, 5, 6, 7); o[d0] = MFMA32(pa[ks], vfr, o[d0]); } }
        asm volatile("s_waitcnt lgkmcnt(0)" ::: "memory");
        LAS bf16* stg = (LAS bf16*)(L + AL_OST) + w * 2048;
#pragma unroll
        for (int r = 0; r < 16; ++r) { const int orow = crow(r, hi); const float rl = __builtin_amdgcn_rcpf(wsf[32 + orow]);
#pragma unroll
            for (int d0 = 0; d0 < 2; ++d0) stg[orow * 64 + d0 * 32 + r32] = (bf16)f2bf(o[d0][r] * rl); }
        asm volatile("s_waitcnt lgkmcnt(0)" ::: "memory");
        bf16* Ow = F.MIX + (size_t)(b * SEQ + 128 * n + 32 * qs) * DM + HW + head * AHD;
#pragma unroll
        for (int i = 0; i < 4; ++i) { const int row = i * 8 + (lane >> 3), ch = lane & 7; const v4u v = *(const LAS v4u*)(stg + row * 64 + ch * 8); *(v4u*)(Ow + (size_t)row * DM + ch * 8) = v; }
        asm volatile("s_waitcnt lgkmcnt(0)" ::: "memory");
    }
    __syncthreads();
}

struct Args { const float* in[16]; float* out; unsigned char* ws; int ph_lo, ph_hi; };
constexpr int N_PHASES = 11;
__global__ void __launch_bounds__(NWAVES * 64, 2) mk_fwd(Args args) {
    extern __shared__ __attribute__((aligned(16))) unsigned char lds[];
    Frame F;
    F.lds = (LAS unsigned char*)lds;
    F.MISC = (volatile LAS unsigned*)(F.lds + MISC_OFF);
    F.tid = threadIdx.x; F.lane = F.tid & 63; F.wave = __builtin_amdgcn_readfirstlane(F.tid >> 6);
    F.G = gridDim.x; { const int bx = blockIdx.x; F.vcu = (F.G % 8 == 0) ? (bx % 8) * (F.G / 8) + bx / 8 : bx; }
    unsigned char* ws = args.ws;
    F.ctl = (gu32*)(ws + WS_CTL);
    F.x = args.in[0]; F.c = args.in[1]; F.w_ada = args.in[2]; F.b_ada = args.in[3]; F.norm1_w = args.in[4]; F.w_in = args.in[5]; F.lower_bounds = args.in[6]; F.hgrn_norm_w = args.in[7];
    F.sinks = args.in[8]; F.rel = args.in[9]; F.w_out = args.in[10]; F.norm2_w = args.in[11]; F.w_gate = args.in[12]; F.w_up = args.in[13]; F.w_down = args.in[14]; F.final_w = args.in[15];
    F.out = args.out; F.mod = (float*)(ws + WS_MOD);
    F.Wt_in = (bf16*)(ws + WS_WIN); F.Wt_out = (bf16*)(ws + WS_WOUT); F.Wt_gu = (bf16*)(ws + WS_WGU); F.Wt_dn = (bf16*)(ws + WS_WDN);
    F.Send = (float*)(ws + WS_SEND); F.Sst = (float*)(ws + WS_SST); F.Dg = (float*)(ws + WS_DG);
    F.H = (bf16*)(ws + WS_H); F.MIX = (bf16*)(ws + WS_MIX); F.PROJ = (bf16*)(ws + WS_PROJ);
    for (int u = F.tid; u < (LDS_BYTES - LDSCTL_OFF) / 4; u += NWAVES * 64) ((LAS unsigned*)(F.lds + LDSCTL_OFF))[u] = 0u;
    __syncthreads();
    const int lo = args.ph_lo, hi = args.ph_hi;
    const bool fused = (hi - lo) > 1;
    XcdBarrier bar; bar.bar = (unsigned*)(F.ctl + CW_BAR); bar.x = 0; bar.st = nullptr;
    if (fused) bar = xcd_barrier_post((unsigned*)(F.ctl + CW_BAR), F.MISC + 8);
#define IN(k) (lo <= (k) && (k) < hi)
#define SEAM(k) do { if (IN(k) && IN((k) + 1)) xcd_barrier(bar); } while (0)

    if (IN(0)) { p0a_prologue(F); } SEAM(0);
    if (IN(1)) { norm_mod_pass(F, F.x, F.norm1_w, 0, DM, F.H); } SEAM(1);
    if (IN(2)) { pg8::Gemm g{F.H, F.Wt_in, M, INW, DM}; pg8::StaticOrder S; S.init(M, INW, F.G, (int)blockIdx.x);
        pg8::EpiBf16Plain E{F.PROJ, INW};
        pg8::gemm_phase<pg8::EpiBf16Plain, pg8::StaticOrder, true, true>(F.lds + RING_OFF, g, S, E); } SEAM(2);
    if (IN(3)) { for (int u = F.vcu; u < 256; u += F.G) hgrn_group<false>(F, u); } SEAM(3);
    if (IN(4)) { hgrn_scan(F); for (int u = F.vcu; u < BATCH * 64 * AKV; u += F.G) attn_unit(F, u); } SEAM(4);
    if (IN(5)) { for (int u = F.vcu; u < 256; u += F.G) hgrn_group<true>(F, u); } SEAM(5);
    if (IN(6)) { pg8::Gemm g{F.MIX, F.Wt_out, M, DM, DM}; pg8::StaticOrder S; S.init(M, DM, F.G, (int)blockIdx.x);
        pg8::EpiResGate E{F.x, F.out, DM, F.mod + 2 * DM, F.b_ada + 2 * DM, MODW, SEQ / 256};
        pg8::gemm_phase<pg8::EpiResGate, pg8::StaticOrder, true, true>(F.lds + RING_OFF, g, S, E); } SEAM(6);
    if (IN(7)) { norm_mod_pass(F, F.out, F.norm2_w, 3 * DM, 4 * DM, F.H); } SEAM(7);
    if (IN(8)) { pg8::Gemm g{F.H, F.Wt_gu, M, 2 * DFF, DM}; pg8::StaticOrder S; S.init(M, 2 * DFF, F.G, (int)blockIdx.x);
        pg8::EpiSwiGLU E{F.PROJ, DFF};
        pg8::gemm_phase<pg8::EpiSwiGLU, pg8::StaticOrder, true, true>(F.lds + RING_OFF, g, S, E); } SEAM(8);
    if (IN(9)) { pg8::Gemm g{F.PROJ, F.Wt_dn, M, DM, DFF}; pg8::StaticOrder S; S.init(M, DM, F.G, (int)blockIdx.x);
        pg8::EpiResGate E{F.out, F.out, DM, F.mod + 5 * DM, F.b_ada + 5 * DM, MODW, SEQ / 256};
        pg8::gemm_phase<pg8::EpiResGate, pg8::StaticOrder, true, true>(F.lds + RING_OFF, g, S, E); } SEAM(9);
    if (IN(10)) { final_norm_pass(F); }
#undef IN
#undef SEAM
}

extern "C" void kernel_launch(void* const* d_in, const int* in_sizes, int n_in, void* d_out, int out_size, void* d_ws, size_t ws_size, hipStream_t stream) {
    static int grid = 0;
    if (grid == 0) {
        if (n_in != 16 || in_sizes[0] != M * DM || out_size != M * DM || ws_size < WS_END) { fprintf(stderr, "kernel_launch: unexpected shapes (n_in %d, in0 %d, out %d, ws %zu); nothing launched\n", n_in, n_in > 0 ? in_sizes[0] : -1, out_size, ws_size); grid = -1; return; }
        int dev = 0, cus = 0, per_cu = 0;
        if (hipGetDevice(&dev) != hipSuccess || hipDeviceGetAttribute(&cus, hipDeviceAttributeMultiprocessorCount, dev) != hipSuccess) { fprintf(stderr, "kernel_launch: device query failed\n"); grid = -1; return; }
        if (hipFuncSetAttribute((const void*)mk_fwd, hipFuncAttributeMaxDynamicSharedMemorySize, LDS_BYTES) != hipSuccess) { fprintf(stderr, "kernel_launch: hipFuncSetAttribute failed\n"); grid = -1; return; }
        if (hipOccupancyMaxActiveBlocksPerMultiprocessor(&per_cu, (const void*)mk_fwd, NWAVES * 64, LDS_BYTES) != hipSuccess || per_cu < 1) { fprintf(stderr, "kernel_launch: occupancy query reports %d blocks per CU; nothing launched\n", per_cu); (void)hipGetLastError(); grid = -1; return; }
        grid = cus;
        fprintf(stderr, "kernel_launch: grid %d (cus %d, occupancy %d per CU)\n", grid, cus, per_cu);
    }
    if (grid < 0) return;
    if (hipMemsetAsync((char*)d_ws + WS_CTL, 0, CTL_ZERO_BYTES, stream) != hipSuccess) { fprintf(stderr, "kernel_launch: memset failed\n"); return; }
    Args a{};
    for (int i = 0; i < 16; ++i) a.in[i] = (const float*)d_in[i];
    a.out = (float*)d_out; a.ws = (unsigned char*)d_ws;
#ifndef MK_N_LAUNCHES
#define MK_N_LAUNCHES 1
#endif
    if (MK_N_LAUNCHES == 1) { a.ph_lo = 0; a.ph_hi = N_PHASES; hipLaunchKernelGGL(mk_fwd, dim3(grid), dim3(NWAVES * 64), LDS_BYTES, stream, a); }
    else for (int p = 0; p < N_PHASES; ++p) { a.ph_lo = p; a.ph_hi = p + 1; hipLaunchKernelGGL(mk_fwd, dim3(grid), dim3(NWAVES * 64), LDS_BYTES, stream, a); }
    const hipError_t le = hipPeekAtLastError();
    if (le != hipSuccess) fprintf(stderr, "kernel_launch: launch failed: %s\n", hipGetErrorName(le));
}
```

```cpp
#include <hip/hip_runtime.h>
#include <cstdio>
#include <cstdint>
namespace pg8 {
#define PG8_LAS __attribute__((address_space(3)))
typedef unsigned short bf16_t;
typedef short bf16x8 __attribute__((ext_vector_type(8)));
typedef float f32x4 __attribute__((ext_vector_type(4)));
typedef unsigned u32x4 __attribute__((ext_vector_type(4)));
constexpr int BM = 256, BK = 64, HALF = 128, HTB = HALF * BK * 2  , STAGE_BYTES = 8 * HTB, NXCD = 8, WGM = 8;

__host__ __device__ __forceinline__ int lds_byte(int r, int c) { const int st = (r >> 4) * 2 + (c >> 5), rr = r & 15, cc = c & 31, ob = rr * 64 + cc * 2; return st * 1024 + (ob ^ (((ob >> 9) & 1) << 5)); }
__host__ __device__ __forceinline__ void stage_rc(int b, int& R, int& C) { const int st = b / 1024, sb = b % 1024, swz = sb ^ (((sb >> 9) & 1) << 5); R = (st >> 1) * 16 + swz / 64; C = (st & 1) * 32 + (swz % 64) / 2; }
__host__ __device__ __forceinline__ int perm32(int rho) { const int n = rho >> 4, i = rho & 15; return 8 * (i >> 2) + 4 * n + (i & 3); }

struct Unit { int pm, pn; };
struct Gemm { const bf16_t* A; const bf16_t* Bt; int M, N, K; };

struct StaticOrder {
    int nM, nN, nwg, G, c;
    __host__ __device__ void init(int M, int N, int G_, int c_) { nM = M / BM; nN = N / BM; nwg = nM * nN; G = G_; c = c_; }
    __host__ __device__ bool next(int i, Unit& u) const {
        const long L = (long)i * G + c; if (L >= nwg) return false;
        int wgid = (int)L; { const int q = nwg / NXCD, r = nwg % NXCD, xcd = wgid % NXCD, off = wgid / NXCD; wgid = (xcd < r ? xcd * (q + 1) : r * (q + 1) + (xcd - r) * q) + off; }
        const int nig = WGM * nN, gid = wgid / nig, fm = gid * WGM, gsz = (nM - fm) < WGM ? (nM - fm) : WGM;
        u.pm = fm + ((wgid % nig) % gsz); u.pn = (wgid % nig) / gsz; return true;
    }
    __device__ __forceinline__ void a_ready(const Unit&) const {}
    __device__ __forceinline__ void done(const Unit&) const {}
};


__device__ __forceinline__ unsigned cvt_pk_bf16(float lo, float hi) { unsigned r; asm volatile("v_cvt_pk_bf16_f32 %0, %1, %2" : "=v"(r) : "v"(lo), "v"(hi)); return r; }

struct EpiBf16Plain {
    static constexpr bool PERM = true, AFTER_DRAIN = false;
    bf16_t* O; int ldc;
    __device__ __forceinline__ void operator()(const f32x4 (&acc)[2][2][4][2], const Unit& u, int wr, int wc, int fr, int fq) const {
        const int row0 = u.pm * BM + wr * 64 + fr, col0 = u.pn * BM + wc * 32 + 8 * fq;
#pragma unroll
        for (int ai = 0; ai < 2; ++ai)
#pragma unroll
            for (int m = 0; m < 4; ++m) { bf16_t* rowp = O + (size_t)(row0 + ai * HALF + m * 16) * ldc + col0;
#pragma unroll
                for (int bj = 0; bj < 2; ++bj) { const f32x4 v0 = acc[ai][bj][m][0], v1 = acc[ai][bj][m][1];
                    u32x4 w; w.x = cvt_pk_bf16(v0[0], v0[1]); w.y = cvt_pk_bf16(v0[2], v0[3]); w.z = cvt_pk_bf16(v1[0], v1[1]); w.w = cvt_pk_bf16(v1[2], v1[3]);
                    *(u32x4*)(rowp + bj * HALF) = w; } }
    }
};
struct EpiResGate {
    static constexpr bool PERM = false, AFTER_DRAIN = false;
    const float* base; float* out; int ldc; const float* gacc; const float* gbias; int gstride; int pm_per_batch;
    __device__ __forceinline__ void operator()(const f32x4 (&acc)[2][2][4][2], const Unit& u, int wr, int wc, int fr, int fq) const {
        const int col0 = u.pn * BM + wc * 32 + 4 * fq; const int b = u.pm / pm_per_batch;
        f32x4 gv[2][2];
#pragma unroll
        for (int bj = 0; bj < 2; ++bj)
#pragma unroll
            for (int n = 0; n < 2; ++n) gv[bj][n] = *(const f32x4*)(gacc + (size_t)b * gstride + col0 + bj * HALF + n * 16) + *(const f32x4*)(gbias + col0 + bj * HALF + n * 16);
#pragma unroll
        for (int ai = 0; ai < 2; ++ai)
#pragma unroll
            for (int m = 0; m < 4; ++m) { const size_t off = (size_t)(u.pm * BM + ai * HALF + wr * 64 + m * 16 + fr) * ldc + col0;
#pragma unroll
                for (int bj = 0; bj < 2; ++bj)
#pragma unroll
                    for (int n = 0; n < 2; ++n) { const f32x4 bs = *(const f32x4*)(base + off + bj * HALF + n * 16);
                        *(f32x4*)(out + off + bj * HALF + n * 16) = bs + gv[bj][n] * acc[ai][bj][m][n]; } }
    }
};
struct EpiSwiGLU {
    static constexpr bool PERM = true, AFTER_DRAIN = false;
    bf16_t* O; int ldc;
    __device__ __forceinline__ void operator()(const f32x4 (&acc)[2][2][4][2], const Unit& u, int wr, int wc, int fr, int fq) const {
        const int row0 = u.pm * BM + wr * 64 + fr, col0 = u.pn * HALF + wc * 32 + 8 * fq;
#pragma unroll
        for (int ai = 0; ai < 2; ++ai)
#pragma unroll
            for (int m = 0; m < 4; ++m) { bf16_t* rowp = O + (size_t)(row0 + ai * HALF + m * 16) * ldc + col0;
                float r[8];
#pragma unroll
                for (int n = 0; n < 2; ++n)
#pragma unroll
                    for (int j = 0; j < 4; ++j) { const float g = acc[ai][0][m][n][j], up = acc[ai][1][m][n][j];
                        const float sg = g * __builtin_amdgcn_rcpf(1.0f + __builtin_amdgcn_exp2f(-1.4426950408889634f * g)); r[n * 4 + j] = sg * up; }
                u32x4 w; w.x = cvt_pk_bf16(r[0], r[1]); w.y = cvt_pk_bf16(r[2], r[3]); w.z = cvt_pk_bf16(r[4], r[5]); w.w = cvt_pk_bf16(r[6], r[7]);
                *(u32x4*)(rowp) = w; }
    }
};

template <class Epi, class Sched, bool ALIGN_EPI = false, bool SP2 = false>
__device__ __forceinline__ void gemm_phase(PG8_LAS unsigned char* lds, const Gemm g, const Sched& S, const Epi& E) {
    const int tid = threadIdx.x, wid = __builtin_amdgcn_readfirstlane(tid >> 6), lane = tid & 63, wr = wid >> 2, wc = wid & 3, fr = lane & 15, fq = lane >> 4;
    const int K = g.K, nt = K / BK;
    unsigned voffA[2], voffB[2];
#pragma unroll
    for (int i = 0; i < 2; ++i) { int R, C; stage_rc(tid * 16 + i * 8192, R, C); const int Rb = Epi::PERM ? ((R & ~31) + perm32(R & 31)) : R;
        voffA[i] = (unsigned)(R * K + C) * 2u; voffB[i] = (unsigned)(Rb * K + C) * 2u; }
    const size_t kstep = (size_t)(BK * 2);
    const size_t hstep = (size_t)HALF * K * 2;
    const size_t tstep = 2 * hstep;
    const unsigned ldsw = (unsigned)wid * 1024u;
    const int aoff = lds_byte(wr * 64 + fr, fq * 8), boff = lds_byte(wc * 32 + fr, fq * 8);
#define PG8_SA(b, h) (((b) * 2 + (h)) * HTB)
#define PG8_SB(b, h) ((4 + (b) * 2 + (h)) * HTB)
#define PG8_STAGE(bufoff, gbase, voff) do { _Pragma("unroll") for (int _i = 0; _i < 2; ++_i) \
        __builtin_amdgcn_global_load_lds((const unsigned*)((const char*)(gbase) + (voff)[_i]), (PG8_LAS unsigned*)(lds + (bufoff) + ldsw + _i * 8192), 16, 0, 0); } while (0)
#define PG8_LDA(dst, b, h) do { _Pragma("unroll") for (int m = 0; m < 4; ++m) _Pragma("unroll") for (int k = 0; k < 2; ++k) dst[m][k] = *(const PG8_LAS bf16x8*)(lds + PG8_SA(b, h) + aoff + m * 2048 + k * 1024); } while (0)
#define PG8_LDB(dst, b, h) do { _Pragma("unroll") for (int n = 0; n < 2; ++n) _Pragma("unroll") for (int k = 0; k < 2; ++k) dst[n][k] = *(const PG8_LAS bf16x8*)(lds + PG8_SB(b, h) + boff + n * 2048 + k * 1024); } while (0)
#define PG8_MMA(ai, bj, At, Bt) do { __builtin_amdgcn_s_setprio(1); _Pragma("unroll") for (int m = 0; m < 4; ++m) _Pragma("unroll") for (int n = 0; n < 2; ++n) _Pragma("unroll") for (int k = 0; k < 2; ++k) \
        acc[ai][bj][m][n] = __builtin_amdgcn_mfma_f32_16x16x32_bf16(Bt[n][k], At[m][k], acc[ai][bj][m][n], 0, 0, 0); __builtin_amdgcn_s_setprio(0); } while (0)
#define PG8_WAIT_V(n) asm volatile("s_waitcnt vmcnt(" #n ")" ::: "memory")
#define PG8_WAIT_L(n) asm volatile("s_waitcnt lgkmcnt(" #n ")" ::: "memory")
#define PG8_BAR __builtin_amdgcn_s_barrier()
#define PG8_SCHED __builtin_amdgcn_sched_barrier(0)
    Unit cur, nxt; int ui = 0;
    if (!S.next(0, cur)) return;
    f32x4 acc[2][2][4][2];
#pragma unroll
    for (int a = 0; a < 2; ++a)
#pragma unroll
        for (int b = 0; b < 2; ++b)
#pragma unroll
            for (int m = 0; m < 4; ++m)
#pragma unroll
                for (int n = 0; n < 2; ++n) acc[a][b][m][n] = (f32x4){0.f, 0.f, 0.f, 0.f};
    bf16x8 At[4][2], B0[2][2], B1[2][2];
    const char* cA = (const char*)g.A + (size_t)cur.pm * tstep; const char* cB = (const char*)g.Bt + (size_t)cur.pn * tstep;
    S.a_ready(cur);
    if constexpr (SP2) {
        PG8_STAGE(PG8_SB(0, 0), cB, voffB); PG8_STAGE(PG8_SB(0, 1), cB + hstep, voffB); PG8_STAGE(PG8_SA(0, 0), cA, voffA); PG8_STAGE(PG8_SA(0, 1), cA + hstep, voffA);
        if (wr == 1) PG8_BAR;
        PG8_WAIT_V(2); PG8_BAR;
        PG8_STAGE(PG8_SB(1, 0), cB + kstep, voffB); PG8_STAGE(PG8_SA(1, 0), cA + kstep, voffA); PG8_STAGE(PG8_SB(1, 1), cB + hstep + kstep, voffB);
        PG8_WAIT_V(6); PG8_BAR;
    } else {
        PG8_STAGE(PG8_SB(0, 0), cB, voffB); PG8_STAGE(PG8_SA(0, 0), cA, voffA); PG8_STAGE(PG8_SB(0, 1), cB + hstep, voffB); PG8_STAGE(PG8_SA(0, 1), cA + hstep, voffA);
        if (wr == 1) PG8_BAR;
        PG8_WAIT_V(4); PG8_BAR;
        PG8_STAGE(PG8_SB(1, 0), cB + kstep, voffB); PG8_STAGE(PG8_SA(1, 0), cA + kstep, voffA); PG8_STAGE(PG8_SB(1, 1), cB + hstep + kstep, voffB);
        PG8_WAIT_V(6); PG8_BAR;
    }
    for (;;) {
        const bool has_next = S.next(ui + 1, nxt);
        const char* nA = has_next ? (const char*)g.A + (size_t)nxt.pm * tstep : cA; const char* nB = has_next ? (const char*)g.Bt + (size_t)nxt.pn * tstep : cB;
        for (int t = 0; t < nt; t += 2) {
            const bool last = (t == nt - 2);
            const char* a1 = cA + (size_t)(t + 1) * kstep;
            const char* a2 = last ? nA : cA + (size_t)(t + 2) * kstep; const char* b2 = last ? nB : cB + (size_t)(t + 2) * kstep;
            const char* a3 = a2 + kstep; const char* b3 = b2 + kstep;
            if (last && has_next) S.a_ready(nxt);
            if constexpr (SP2) {
            PG8_LDB(B0, 0, 0); PG8_LDB(B1, 0, 1); PG8_SCHED; PG8_LDA(At, 0, 0); PG8_STAGE(PG8_SA(1, 1), a1 + hstep, voffA);
            PG8_WAIT_V(8); PG8_WAIT_L(0); PG8_BAR; PG8_MMA(0, 0, At, B0); PG8_MMA(0, 1, At, B1); PG8_BAR; PG8_SCHED;
            PG8_LDA(At, 0, 1); PG8_STAGE(PG8_SB(0, 0), b2, voffB); PG8_STAGE(PG8_SB(0, 1), b2 + hstep, voffB); PG8_STAGE(PG8_SA(0, 0), a2, voffA);
            PG8_WAIT_V(8); PG8_WAIT_L(0); PG8_BAR; PG8_MMA(1, 0, At, B0); PG8_MMA(1, 1, At, B1); PG8_BAR; PG8_SCHED;
            PG8_LDB(B0, 1, 0); PG8_LDB(B1, 1, 1); PG8_SCHED; PG8_LDA(At, 1, 0); PG8_STAGE(PG8_SA(0, 1), a2 + hstep, voffA);
            PG8_WAIT_V(8); PG8_WAIT_L(0); PG8_BAR; PG8_MMA(0, 0, At, B0); PG8_MMA(0, 1, At, B1); PG8_BAR; PG8_SCHED;
            PG8_LDA(At, 1, 1); PG8_STAGE(PG8_SB(1, 0), b3, voffB); PG8_STAGE(PG8_SB(1, 1), b3 + hstep, voffB); PG8_STAGE(PG8_SA(1, 0), a3, voffA);
            PG8_WAIT_V(8); PG8_WAIT_L(0); PG8_BAR; PG8_MMA(1, 0, At, B0); PG8_MMA(1, 1, At, B1); PG8_BAR; PG8_SCHED;
            } else {
            PG8_LDB(B0, 0, 0); PG8_SCHED; PG8_LDA(At, 0, 0); PG8_STAGE(PG8_SA(1, 1), a1 + hstep, voffA);
            PG8_WAIT_L(8); PG8_BAR; PG8_WAIT_L(0); PG8_MMA(0, 0, At, B0); PG8_BAR; PG8_SCHED;
            PG8_LDB(B1, 0, 1); PG8_STAGE(PG8_SB(0, 0), b2, voffB);
            PG8_BAR; PG8_WAIT_L(0); PG8_MMA(0, 1, At, B1); PG8_BAR;
            PG8_LDA(At, 0, 1); PG8_STAGE(PG8_SA(0, 0), a2, voffA);
            PG8_BAR; PG8_WAIT_L(0); PG8_MMA(1, 0, At, B0); PG8_BAR; PG8_SCHED;
            PG8_STAGE(PG8_SB(0, 1), b2 + hstep, voffB);
            PG8_WAIT_V(6); PG8_BAR; PG8_MMA(1, 1, At, B1); PG8_BAR;
            PG8_LDB(B0, 1, 0); PG8_SCHED; PG8_LDA(At, 1, 0); PG8_STAGE(PG8_SA(0, 1), a2 + hstep, voffA);
            PG8_WAIT_L(8); PG8_BAR; PG8_WAIT_L(0); PG8_MMA(0, 0, At, B0); PG8_BAR; PG8_SCHED;
            PG8_LDB(B1, 1, 1); PG8_STAGE(PG8_SB(1, 0), b3, voffB);
            PG8_BAR; PG8_WAIT_L(0); PG8_MMA(0, 1, At, B1); PG8_BAR;
            PG8_LDA(At, 1, 1); PG8_STAGE(PG8_SA(1, 0), a3, voffA);
            PG8_BAR; PG8_WAIT_L(0); PG8_MMA(1, 0, At, B0); PG8_BAR; PG8_SCHED;
            PG8_STAGE(PG8_SB(1, 1), b3 + hstep, voffB);
            PG8_WAIT_V(6); PG8_BAR; PG8_MMA(1, 1, At, B1); PG8_BAR;
            }
        }
        if constexpr (ALIGN_EPI) { if (wr == 0) PG8_BAR; }
        if constexpr (!Epi::AFTER_DRAIN) { E(acc, cur, wr, wc, fr, fq); S.done(cur); }
        if (!has_next) break;
#pragma unroll
        for (int a = 0; a < 2; ++a)
#pragma unroll
            for (int b = 0; b < 2; ++b)
#pragma unroll
                for (int m = 0; m < 4; ++m)
#pragma unroll
                    for (int n = 0; n < 2; ++n) acc[a][b][m][n] = (f32x4){0.f, 0.f, 0.f, 0.f};
        cur = nxt; cA = nA; cB = nB; ++ui;
        if constexpr (ALIGN_EPI) { if (wr == 1) PG8_BAR; }
    }
    PG8_WAIT_V(0);
    if constexpr (!ALIGN_EPI) { if (wr == 0) PG8_BAR; }
    PG8_BAR;
    if constexpr (Epi::AFTER_DRAIN) { E.fused(acc, cur, wr, wc, fr, fq, lds, wid, lane); S.done(cur); }
#undef PG8_SA
#undef PG8_SB
#undef PG8_STAGE
#undef PG8_LDA
#undef PG8_LDB
#undef PG8_MMA
#undef PG8_WAIT_V
#undef PG8_WAIT_L
#undef PG8_BAR
#undef PG8_SCHED
}
}
#define GAS __attribute__((address_space(1)))
#define LAS __attribute__((address_space(3)))
typedef unsigned short bf16;
typedef unsigned v4u __attribute__((ext_vector_type(4)));
typedef float f32x4 __attribute__((ext_vector_type(4)));
typedef short bf16x8 __attribute__((ext_vector_type(8)));
typedef GAS unsigned gu32;
typedef GAS unsigned long long gu64;
#define RLX_AGENT __ATOMIC_RELAXED, __HIP_MEMORY_SCOPE_AGENT
#define LDS_WAIT() asm volatile("s_waitcnt lgkmcnt(0)" ::: "memory")
#define VM_WAIT() asm volatile("s_waitcnt vmcnt(0)" ::: "memory")
__device__ __forceinline__ unsigned long long rt() { return __builtin_amdgcn_s_memrealtime(); }
__device__ __forceinline__ unsigned f2bf(float f) { unsigned u = __builtin_bit_cast(unsigned, f); return (u + 0x7fffu + ((u >> 16) & 1u)) >> 16; }
__device__ __forceinline__ unsigned pk2(float lo, float hi) { return f2bf(lo) | (f2bf(hi) << 16); }

#define XB_TMO      128
#define XB_XCNT(j)  (256  + 64 * (j))
#define XB_XSUB(j)  (1280 + 64 * (j))
#define XB_XGEN(j)  (2304 + 64 * (j))
#define XB_TOP      3328
#define XB_TOPGEN   3392
#define XCD_BAR_WORDS 3456
#define XB_SPIN_CAP (1u << 18)

__device__ __forceinline__ unsigned xb_ld(unsigned* p)              { return __hip_atomic_load(p, __ATOMIC_RELAXED, __HIP_MEMORY_SCOPE_AGENT); }
__device__ __forceinline__ unsigned xb_add(unsigned* p, unsigned v) { return __hip_atomic_fetch_add(p, v, __ATOMIC_RELAXED, __HIP_MEMORY_SCOPE_AGENT); }
__device__ __forceinline__ unsigned xb_xcc_id() { return (unsigned)__builtin_amdgcn_s_getreg((3 << 11) | 20) & 0xFu; }
#define XB_SPIN(cond, bar) do { unsigned _sp = 0; while (cond) { __builtin_amdgcn_s_sleep(1); \
    if ((++_sp & 255u) == 0u) { if (xb_ld(&(bar)[XB_TMO])) break; if (_sp > XB_SPIN_CAP) { atomicAdd(&(bar)[XB_TMO], 1u); break; } } } } while (0)

struct XcdBarrier {
    unsigned* bar; unsigned x;
    volatile LAS unsigned* st;
};

__device__ __forceinline__ XcdBarrier xcd_barrier_post(unsigned* bar, volatile LAS unsigned* st) {
    XcdBarrier b; b.bar = bar; b.x = xb_xcc_id(); b.st = st;
    if (threadIdx.x == 0) (void)xb_add(&bar[XB_XCNT(b.x)], 1u);
    return b;
}
__device__ __forceinline__ void xcd_barrier_complete(unsigned* bar, unsigned x, unsigned& nloc, unsigned& nx) {
    const unsigned G = gridDim.x * gridDim.y * gridDim.z;
    unsigned sum, cnt, mine, sp = 0u;
    for (;;) {
        sum = 0u; cnt = 0u; mine = 0u;
#pragma unroll
        for (unsigned j = 0; j < 16; ++j) { const unsigned c = xb_ld(&bar[XB_XCNT(j)]); sum += c; cnt += (c > 0u) ? 1u : 0u; mine = (j == x) ? c : mine; }
        if (sum == G) break;
        __builtin_amdgcn_s_sleep(1);
        if ((++sp & 255u) == 0u) { if (xb_ld(&bar[XB_TMO])) break; if (sp > XB_SPIN_CAP) { atomicAdd(&bar[XB_TMO], 1u); break; } }
    }
    nloc = mine > 0u ? mine : 1u; nx = cnt > 0u ? cnt : 1u;
}

__device__ __forceinline__ void xcd_barrier(const XcdBarrier& b) {
    asm volatile("s_waitcnt vmcnt(0)" ::: "memory");
    __syncthreads();
    if (threadIdx.x == 0) {
        unsigned* bar = b.bar;
        __builtin_amdgcn_s_waitcnt(0);
        unsigned nloc = b.st[0], nx = b.st[1];
        if (nloc == 0u) { xcd_barrier_complete(bar, b.x, nloc, nx); b.st[0] = nloc; b.st[1] = nx; }
        const unsigned old = xb_add(&bar[XB_XSUB(b.x)], 1u);
        const unsigned gen = old / nloc;
        if (old + 1u == (gen + 1u) * nloc) {
            __builtin_amdgcn_fence(__ATOMIC_RELEASE, "agent");
            asm volatile("s_waitcnt vmcnt(0)" ::: "memory");
            const unsigned og = xb_add(&bar[XB_TOP], 1u);
            const unsigned tg = og / nx;
            if (og + 1u == (tg + 1u) * nx) xb_add(&bar[XB_TOPGEN], 1u);
            else XB_SPIN(xb_ld(&bar[XB_TOPGEN]) == tg, bar);
            __builtin_amdgcn_fence(__ATOMIC_ACQUIRE, "agent");
            xb_add(&bar[XB_XGEN(b.x)], 1u);
            asm volatile("s_waitcnt vmcnt(0)" ::: "memory");
        } else {
            XB_SPIN(xb_ld(&bar[XB_XGEN(b.x)]) == gen, bar);
            __builtin_amdgcn_fence(__ATOMIC_ACQUIRE, "agent");
            asm volatile("s_waitcnt vmcnt(0)" ::: "memory");
        }
    }
    __syncthreads();
}


constexpr int NWAVES = 8;
constexpr int BATCH = 2, SEQ = 8192, DM = 2048, M = BATCH * SEQ;
constexpr int INW = 5632, DFF = 5632, HW = 1024, NHH = 8, HHD = 128, AQH = 16, AKV = 4, AHD = 64;
constexpr int COL_HQ = 0, COL_HF = 1024, COL_HI = 2048, COL_HG = 3072, COL_AQ = 4096, COL_AK = 5120, COL_AV = 5376;
constexpr int MODW = 6 * DM;
constexpr float EPS = 1e-6f;
constexpr size_t MiB = 1u << 20;
constexpr size_t WS_CTL = 0, CTL_ZERO_BYTES = 1 * MiB;
constexpr size_t WS_MOD = 512 * 1024;
constexpr size_t WS_WIN = 2 * MiB, WS_WOUT = 24 * MiB, WS_WGU = 32 * MiB, WS_WDN = 76 * MiB;
constexpr size_t WS_H = 100 * MiB;
constexpr size_t WS_MIX = 164 * MiB;
constexpr size_t WS_PROJ = 228 * MiB;
constexpr size_t WS_SEND = 404 * MiB, WS_SST = 420 * MiB, WS_DG = 436 * MiB;
constexpr size_t WS_END = 437 * MiB;
constexpr int CW_TMO = 0, CW_CODE = 1, CW_BAR = 4096;
constexpr int RING_OFF = 0, RING_BYTES = 131072;
constexpr int LDSCTL_OFF = RING_BYTES, MISC_OFF = LDSCTL_OFF + 320;
constexpr int LDS_BYTES = 147456;

__device__ const int T5_BUCKET[128] = {0,1,2,3,4,5,6,7,8,9,10,11,12,13,14,15,16,16,16,17,17,18,18,18,19,19,19,20,20,20,20,21,21,21,21,22,22,22,22,22,23,23,23,23,23,23,24,24,24,24,24,24,25,25,25,25,25,25,25,26,26,26,26,26,26,26,26,27,27,27,27,27,27,27,27,27,27,28,28,28,28,28,28,28,28,28,28,29,29,29,29,29,29,29,29,29,29,29,29,30,30,30,30,30,30,30,30,30,30,30,30,30,30,31,31,31,31,31,31,31,31,31,31,31,31,31,31,31};

struct Frame {
    LAS unsigned char* lds;
    volatile LAS unsigned* MISC;
    gu32* ctl;
    int tid, lane, wave, vcu, G;
    const float *x, *c, *w_ada, *b_ada, *norm1_w, *w_in, *lower_bounds, *hgrn_norm_w, *sinks, *rel, *w_out, *norm2_w, *w_gate, *w_up, *w_down, *final_w;
    float* out; float* mod; float *Send, *Sst, *Dg;
    bf16 *Wt_in, *Wt_out, *Wt_gu, *Wt_dn, *H, *MIX, *PROJ;
};
__device__ __forceinline__ float bf2f(bf16 v) { return __builtin_bit_cast(float, (unsigned)v << 16); }
__device__ __forceinline__ float wave_sum(float v) {
#pragma unroll
    for (int o = 1; o < 64; o <<= 1) v += __shfl_xor(v, o);
    return v;
}
typedef short v4i16_t __attribute__((ext_vector_type(4)));
typedef float f32x2_t __attribute__((ext_vector_type(2)));
typedef __bf16 bf16x2_t __attribute__((ext_vector_type(2)));
typedef unsigned u32x2_t __attribute__((ext_vector_type(2)));
__device__ __forceinline__ unsigned cvtpk(float lo, float hi) { f32x2_t v = {lo, hi}; bf16x2_t b = __builtin_convertvector(v, bf16x2_t); return __builtin_bit_cast(unsigned, b); }
__device__ __forceinline__ float sigmoidf_(float v) { return __builtin_amdgcn_rcpf(1.0f + __builtin_amdgcn_exp2f(-1.4426950408889634f * v)); }

__device__ __forceinline__ void p0_transpose_item(const float* W, int K, int N, bf16* WT, int drow, LAS unsigned char* scr, int k0, int n0, int lane) {
    const int kq = lane >> 4, nq = lane & 15;
    f32x4 v[16];
#pragma unroll
    for (int j = 0; j < 4; ++j)
#pragma unroll
        for (int i = 0; i < 4; ++i) v[j * 4 + i] = *(const f32x4*)(W + (size_t)(k0 + 16 * j + 4 * kq + i) * N + n0 + 4 * nq);
#pragma unroll
    for (int j = 0; j < 4; ++j)
#pragma unroll
        for (int ni = 0; ni < 4; ++ni) *(LAS u32x2_t*)(scr + (4 * nq + ni) * 144 + (16 * j + 4 * kq) * 2) = (u32x2_t){cvtpk(v[4 * j][ni], v[4 * j + 1][ni]), cvtpk(v[4 * j + 2][ni], v[4 * j + 3][ni])};
    LDS_WAIT(); asm volatile("" ::: "memory");
#pragma unroll
    for (int r = 0; r < 8; ++r) { const int n = (lane >> 3) + 8 * r, kc = lane & 7; const v4u o = *(const LAS v4u*)(scr + n * 144 + kc * 16); *(GAS v4u*)(WT + (size_t)(drow + n) * K + k0 + 8 * kc) = o; }
    LDS_WAIT(); asm volatile("" ::: "memory");
}
__device__ __forceinline__ void p0a_prologue(Frame& F) {
    LAS unsigned char* scr = F.lds + RING_OFF + F.wave * 16384;
    const int gw = F.vcu * NWAVES + F.wave, NGW = F.G * NWAVES;
    for (int it = gw; it < 48 * 32; it += NGW) {
        const int cg = it % 48, ks = it / 48; const int k0 = ks * 64;
        const float c0 = F.c[k0 + F.lane], c1 = F.c[DM + k0 + F.lane];
        const float s0 = c0 * sigmoidf_(c0), s1 = c1 * sigmoidf_(c1);
        f32x4 a0 = {0.f, 0.f, 0.f, 0.f}, a1 = {0.f, 0.f, 0.f, 0.f};
        const float* wp = F.w_ada + (size_t)k0 * MODW + cg * 256 + 4 * F.lane;
#pragma unroll 16
        for (int kk = 0; kk < 64; ++kk) {
            const f32x4 w = *(const f32x4*)(wp + (size_t)kk * MODW);
            const float t0 = __builtin_bit_cast(float, __builtin_amdgcn_readlane(__builtin_bit_cast(int, s0), kk));
            const float t1 = __builtin_bit_cast(float, __builtin_amdgcn_readlane(__builtin_bit_cast(int, s1), kk));
            a0 += w * t0; a1 += w * t1;
        }
        float* m0 = F.mod + cg * 256 + 4 * F.lane; float* m1 = m0 + MODW;
#pragma unroll
        for (int j = 0; j < 4; ++j) { atomicAdd(m0 + j, a0[j]); atomicAdd(m1 + j, a1[j]); }
    }
    constexpr int I_IN = (DM / 64) * (INW / 64), I_OUT = (DM / 64) * (DM / 64), I_G = (DM / 64) * (DFF / 64), I_DN = (DFF / 64) * (DM / 64);
    constexpr int NITEMS = I_IN + I_OUT + 2 * I_G + I_DN;
    for (int it = gw; it < NITEMS; it += NGW) {
        int r = it;
        if (r < I_IN) { const int nb = INW / 64, kb = r / nb, n0 = (r % nb) * 64; p0_transpose_item(F.w_in, DM, INW, F.Wt_in, n0, scr, kb * 64, n0, F.lane); continue; } r -= I_IN;
        if (r < I_OUT) { const int nb = DM / 64, kb = r / nb, n0 = (r % nb) * 64; p0_transpose_item(F.w_out, DM, DM, F.Wt_out, n0, scr, kb * 64, n0, F.lane); continue; } r -= I_OUT;
        if (r < I_G) { const int nb = DFF / 64, kb = r / nb, n0 = (r % nb) * 64; p0_transpose_item(F.w_gate, DM, DFF, F.Wt_gu, (n0 >> 7) * 256 + (n0 & 127), scr, kb * 64, n0, F.lane); continue; } r -= I_G;
        if (r < I_G) { const int nb = DFF / 64, kb = r / nb, n0 = (r % nb) * 64; p0_transpose_item(F.w_up, DM, DFF, F.Wt_gu, (n0 >> 7) * 256 + 128 + (n0 & 127), scr, kb * 64, n0, F.lane); continue; } r -= I_G;
        { const int nb = DM / 64, kb = r / nb, n0 = (r % nb) * 64; p0_transpose_item(F.w_down, DFF, DM, F.Wt_dn, n0, scr, kb * 64, n0, F.lane); }
    }
}
__device__ __forceinline__ void norm_mod_pass(Frame& F, const float* X, const float* nw, int shift_off, int scale_off, bf16* O) {
    const int gw = F.vcu * NWAVES + F.wave, NGW = F.G * NWAVES;
    for (int m = gw; m < M; m += NGW) {
        const int b = m / SEQ;
        const GAS f32x4* xr = (const GAS f32x4*)(X + (size_t)m * DM) + F.lane;
        f32x4 v[8]; float s = 0.f;
#pragma unroll
        for (int j = 0; j < 8; ++j) { v[j] = xr[64 * j]; s += (v[j].x * v[j].x + v[j].y * v[j].y) + (v[j].z * v[j].z + v[j].w * v[j].w); }
        const float rstd = 1.0f / sqrtf(wave_sum(s) * (1.0f / DM) + EPS);
        GAS unsigned long long* o8 = (GAS unsigned long long*)(O + (size_t)m * DM) + F.lane;
#pragma unroll
        for (int j = 0; j < 8; ++j) { const int col = 256 * j + 4 * F.lane;
            const f32x4 w = *(const f32x4*)(nw + col);
            const f32x4 sc = *(const f32x4*)(F.mod + (size_t)b * MODW + scale_off + col) + *(const f32x4*)(F.b_ada + scale_off + col);
            const f32x4 sh = *(const f32x4*)(F.mod + (size_t)b * MODW + shift_off + col) + *(const f32x4*)(F.b_ada + shift_off + col);
            const f32x4 y = v[j] * rstd * w * (sc + 1.0f) + sh;
            o8[64 * j] = (unsigned long long)pk2(y.x, y.y) | ((unsigned long long)pk2(y.z, y.w) << 32); }
    }
}
__device__ __forceinline__ void final_norm_pass(Frame& F) {
    const int gw = F.vcu * NWAVES + F.wave, NGW = F.G * NWAVES;
    for (int m = gw; m < M; m += NGW) {
        GAS f32x4* xr = (GAS f32x4*)(F.out + (size_t)m * DM) + F.lane;
        f32x4 v[8]; float s = 0.f;
#pragma unroll
        for (int j = 0; j < 8; ++j) { v[j] = xr[64 * j]; s += (v[j].x * v[j].x + v[j].y * v[j].y) + (v[j].z * v[j].z + v[j].w * v[j].w); }
        const float rstd = 1.0f / sqrtf(wave_sum(s) * (1.0f / DM) + EPS);
#pragma unroll
        for (int j = 0; j < 8; ++j) { const f32x4 w = *(const f32x4*)(F.final_w + 256 * j + 4 * F.lane); xr[64 * j] = v[j] * rstd * w; }
    }
}
__device__ __forceinline__ v4i16_t vtr(const LAS unsigned char* p) { return __builtin_amdgcn_ds_read_tr16_b64_v4i16((LAS v4i16_t*)p); }
#define MFMA16(a, b, c) __builtin_amdgcn_mfma_f32_16x16x32_bf16((a), (b), (c), 0, 0, 0)
__device__ __forceinline__ int hpi(int q, int rho) { return 32 * (q >> 1) + 8 * (rho >> 2) + 4 * (q & 1) + (rho & 3); }
__device__ __forceinline__ int swzk(int d) { return ((d >> 1) & 1) | (((d >> 3) & 3) << 1); }
__device__ __forceinline__ int swzv(int s) { return (s & 3) | (((s >> 3) & 1) << 2); }
constexpr int HL_QREL = 0, HL_KREL = 16384, HL_QDEC = 32768, HL_KDT = 49152, HL_V = 65536, HL_A = 81920, HL_PT = 90112, HL_DEC = 94208, HL_SS = 94720;
template <bool FULL> __device__ __forceinline__ void hgrn_group(Frame& F, int unit) {
    const int bh = unit >> 4, grp = unit & 15, b = bh >> 3, h = bh & 7;
    const int lane = F.lane, w = F.wave, g = lane >> 4, l16 = lane & 15, tid = F.tid;
    LAS unsigned char* L = F.lds + RING_OFF;
    const size_t row0 = (size_t)b * SEQ + (size_t)grp * 512;
    const bf16* Pg = F.PROJ + row0 * INW + h * HHD;
    const int d0 = 2 * lane;
    float lb0, lb1;
    { const float a0 = F.lower_bounds[h * HHD + d0], a1 = F.lower_bounds[HW + h * HHD + d0], c0 = F.lower_bounds[h * HHD + d0 + 1], c1 = F.lower_bounds[HW + h * HHD + d0 + 1];
      lb0 = 1.0f / (1.0f + __expf(a1 - a0)); lb1 = 1.0f / (1.0f + __expf(c1 - c0)); }
    f32x4 S[8];
    float* Sg = (FULL ? F.Sst : F.Send) + (size_t)unit * 16384;
#pragma unroll
    for (int q = 0; q < 8; ++q)
#pragma unroll
        for (int i = 0; i < 4; ++i) S[q][i] = FULL ? Sg[hpi(q, 4 * g + i) * 128 + 16 * w + l16] : 0.f;
    f32x4 wn = {0.f, 0.f, 0.f, 0.f};
    if (FULL) wn = *(const f32x4*)(F.hgrn_norm_w + h * HHD + 16 * w + 4 * g);
    float dsum0 = 0.f, dsum1 = 0.f;
    for (int ck = 0; ck < 8; ++ck) {
        const bf16* Pc = Pg + (size_t)(ck * 64) * INW;
        unsigned fv[8], qv[8];
#pragma unroll
        for (int tt = 0; tt < 8; ++tt) { const bf16* pr = Pc + (size_t)(8 * w + tt) * INW + d0; fv[tt] = *(const unsigned*)(pr + COL_HF); qv[tt] = FULL ? *(const unsigned*)(pr + COL_HQ) : 0u; }
        v4u vreg[2];
#pragma unroll
        for (int c = 0; c < 2; ++c) { const int idx = tid + 512 * c, s = idx >> 4, c16 = idx & 15; vreg[c] = *(const v4u*)(Pc + (size_t)s * INW + COL_HI + 8 * c16); }
        u32x2_t gq[4];
#pragma unroll
        for (int ti = 0; ti < 4; ++ti) gq[ti] = FULL ? *(const u32x2_t*)(Pc + (size_t)(16 * ti + l16) * INW + COL_HG + 16 * w + 4 * g) : (u32x2_t){0u, 0u};
        float k0[8], k1[8], c0[8], c1[8]; float r0 = 0.f, r1 = 0.f;
#pragma unroll
        for (int tt = 0; tt < 8; ++tt) { const float fl0 = __builtin_bit_cast(float, fv[tt] << 16), fl1 = __builtin_bit_cast(float, fv[tt] & 0xffff0000u);
            const float f0 = lb0 + (1.0f - lb0) * sigmoidf_(fl0), f1 = lb1 + (1.0f - lb1) * sigmoidf_(fl1);
            k0[tt] = 1.0f - f0; k1[tt] = 1.0f - f1; r0 += __builtin_amdgcn_logf(f0); r1 += __builtin_amdgcn_logf(f1); c0[tt] = r0; c1[tt] = r1; }
        *(LAS f32x2_t*)(L + HL_PT + w * 512 + lane * 8) = (f32x2_t){r0, r1};
#pragma unroll
        for (int c = 0; c < 2; ++c) { const int idx = tid + 512 * c, s = idx >> 4, c16 = idx & 15; *(LAS v4u*)(L + HL_V + s * 256 + (((c16 >> 1) ^ swzv(s)) << 5) + (c16 & 1) * 16) = vreg[c]; }
        __syncthreads();
        float pre0 = 0.f, pre1 = 0.f, mid0 = 0.f, mid1 = 0.f, tot0 = 0.f, tot1 = 0.f;
#pragma unroll
        for (int ww = 0; ww < 8; ++ww) { const f32x2_t p = *(const LAS f32x2_t*)(L + HL_PT + ww * 512 + lane * 8);
            if (ww < w) { pre0 += p.x; pre1 += p.y; } if (ww < 4) { mid0 += p.x; mid1 += p.y; } tot0 += p.x; tot1 += p.y; }
        const float cq0 = __builtin_amdgcn_exp2f(mid0), cq1 = __builtin_amdgcn_exp2f(mid1), ck0 = __builtin_amdgcn_exp2f(tot0 - mid0), ck1 = __builtin_amdgcn_exp2f(tot1 - mid1);
        if (w == 0) { *(LAS f32x2_t*)(L + HL_DEC + lane * 8) = (f32x2_t){__builtin_amdgcn_exp2f(tot0), __builtin_amdgcn_exp2f(tot1)}; dsum0 += tot0; dsum1 += tot1; }
        unsigned kd0p[4], kd1p[4]; float kdp0 = 0.f, kdp1 = 0.f;
#pragma unroll
        for (int tt = 0; tt < 8; ++tt) { const int t = 8 * w + tt; const float b0 = pre0 + c0[tt], b1 = pre1 + c1[tt]; float kd0, kd1;
            if (FULL) { const float bm0 = b0 - mid0, bm1 = b1 - mid1;
                const float q0 = __builtin_bit_cast(float, qv[tt] << 16), q1 = __builtin_bit_cast(float, qv[tt] & 0xffff0000u);
                const float qr0 = q0 * __builtin_amdgcn_exp2f(bm0), qr1 = q1 * __builtin_amdgcn_exp2f(bm1), kr0 = k0[tt] * __builtin_amdgcn_exp2f(-bm0), kr1 = k1[tt] * __builtin_amdgcn_exp2f(-bm1);
                const int byte = t * 256 + (((lane >> 2) ^ (t & 15)) << 4) + (lane & 3) * 4;
                *(LAS unsigned*)(L + HL_QREL + byte) = cvtpk(qr0, qr1); *(LAS unsigned*)(L + HL_KREL + byte) = cvtpk(kr0, kr1); *(LAS unsigned*)(L + HL_QDEC + byte) = cvtpk(qr0 * cq0, qr1 * cq1);
                kd0 = kr0 * ck0; kd1 = kr1 * ck1;
            } else { kd0 = k0[tt] * __builtin_amdgcn_exp2f(tot0 - b0); kd1 = k1[tt] * __builtin_amdgcn_exp2f(tot1 - b1); }
            if (tt & 1) { kd0p[tt >> 1] = cvtpk(kdp0, kd0); kd1p[tt >> 1] = cvtpk(kdp1, kd1); } else { kdp0 = kd0; kdp1 = kd1; } }
        *(LAS v4u*)(L + HL_KDT + d0 * 128 + ((w ^ swzk(d0)) << 4)) = (v4u){kd0p[0], kd0p[1], kd0p[2], kd0p[3]};
        *(LAS v4u*)(L + HL_KDT + (d0 + 1) * 128 + ((w ^ swzk(d0 + 1)) << 4)) = (v4u){kd1p[0], kd1p[1], kd1p[2], kd1p[3]};
        __syncthreads();
        bf16x8 vf[2];
#pragma unroll
        for (int ks = 0; ks < 2; ++ks) { const int qq = l16 >> 2, p = l16 & 3, s0 = 32 * ks + 8 * g + qq, s1 = s0 + 4;
            const v4i16_t lo = vtr(L + HL_V + s0 * 256 + ((w ^ swzv(s0)) << 5) + 8 * p), hi = vtr(L + HL_V + s1 * 256 + ((w ^ swzv(s1)) << 5) + 8 * p);
            vf[ks] = __builtin_shufflevector(lo, hi, 0, 1, 2, 3, 4, 5, 6, 7); }
        f32x4 o[4];
        if (FULL) {
            bf16x8 Sf[4];
#pragma unroll
            for (int p = 0; p < 4; ++p) { const v4u pk = {cvtpk(S[2 * p][0], S[2 * p][1]), cvtpk(S[2 * p][2], S[2 * p][3]), cvtpk(S[2 * p + 1][0], S[2 * p + 1][1]), cvtpk(S[2 * p + 1][2], S[2 * p + 1][3])}; Sf[p] = __builtin_bit_cast(bf16x8, pk); }
#pragma unroll
            for (int ti = 0; ti < 4; ++ti) { o[ti] = (f32x4){0.f, 0.f, 0.f, 0.f};
#pragma unroll
                for (int p = 0; p < 4; ++p) { const bf16x8 bq = *(const LAS bf16x8*)(L + HL_QDEC + (16 * ti + l16) * 256 + (((4 * p + g) ^ l16) << 4)); o[ti] = MFMA16(Sf[p], bq, o[ti]); } }
        }
        f32x4 at[2] = {{0.f, 0.f, 0.f, 0.f}, {0.f, 0.f, 0.f, 0.f}};
        if (FULL) {
#pragma unroll
            for (int u = 0; u < 2; ++u) { const int idx = 2 * w + u, si = idx >> 2, ti = idx & 3;
                if (si <= ti) {
#pragma unroll
                    for (int ks = 0; ks < 4; ++ks) { const bf16x8 ak = *(const LAS bf16x8*)(L + HL_KREL + (16 * si + l16) * 256 + (((4 * ks + g) ^ l16) << 4)), bq = *(const LAS bf16x8*)(L + HL_QREL + (16 * ti + l16) * 256 + (((4 * ks + g) ^ l16) << 4));
                        at[u] = MFMA16(ak, bq, at[u]); } } }
        }
#pragma unroll
        for (int q = 0; q < 8; ++q) { const f32x4 dq = *(const LAS f32x4*)(L + HL_DEC + (32 * (q >> 1) + 8 * g + 4 * (q & 1)) * 4); S[q] = S[q] * dq; }
#pragma unroll
        for (int q = 0; q < 8; ++q)
#pragma unroll
            for (int ks = 0; ks < 2; ++ks) { const int d = hpi(q, l16); const bf16x8 ak = *(const LAS bf16x8*)(L + HL_KDT + d * 128 + (((4 * ks + g) ^ swzk(d)) << 4)); S[q] = MFMA16(ak, vf[ks], S[q]); }
        if (FULL) {
            __builtin_amdgcn_sched_barrier(0);
#pragma unroll
            for (int u = 0; u < 2; ++u) { const int idx = 2 * w + u, si = idx >> 2, ti = idx & 3; const bool diag = (si == ti);
                f32x4 acc = at[u];
#pragma unroll
                for (int i = 0; i < 4; ++i) acc[i] = (diag && (4 * g + i > l16)) ? 0.f : acc[i];
                const int t = 16 * ti + l16, s0 = 16 * si + 4 * g;
                *(LAS u32x2_t*)(L + HL_A + t * 128 + (((s0 >> 3) ^ ((t >> 1) & 7)) << 4) + (s0 & 7) * 2) = (u32x2_t){cvtpk(acc[0], acc[1]), cvtpk(acc[2], acc[3])}; }
        }
        if (FULL) {
            __syncthreads();
#pragma unroll
            for (int ti = 0; ti < 4; ++ti)
#pragma unroll
                for (int ks = 0; ks < 2; ++ks) if (ks <= (ti >> 1)) { const int t = 16 * ti + l16; const bf16x8 ba = *(const LAS bf16x8*)(L + HL_A + t * 128 + (((4 * ks + g) ^ ((t >> 1) & 7)) << 4)); o[ti] = MFMA16(vf[ks], ba, o[ti]); }
            float ss[4];
#pragma unroll
            for (int ti = 0; ti < 4; ++ti) { float s = (o[ti][0] * o[ti][0] + o[ti][1] * o[ti][1]) + (o[ti][2] * o[ti][2] + o[ti][3] * o[ti][3]); s += __shfl_xor(s, 16); s += __shfl_xor(s, 32); ss[ti] = s; }
            *(LAS float*)(L + HL_SS + (w * 64 + lane) * 4) = (g == 0) ? ss[0] : (g == 1) ? ss[1] : (g == 2) ? ss[2] : ss[3];
            __syncthreads();
#pragma unroll
            for (int ti = 0; ti < 4; ++ti) { float tot = 0.f;
#pragma unroll
                for (int ww = 0; ww < 8; ++ww) tot += *(const LAS float*)(L + HL_SS + (ww * 64 + 16 * ti + l16) * 4);
                const float rstd = 1.0f / sqrtf(tot * (1.0f / HHD) + EPS);
                const float g0 = __builtin_bit_cast(float, gq[ti].x << 16), g1 = __builtin_bit_cast(float, gq[ti].x & 0xffff0000u), g2 = __builtin_bit_cast(float, gq[ti].y << 16), g3 = __builtin_bit_cast(float, gq[ti].y & 0xffff0000u);
                const float y0 = o[ti][0] * rstd * wn[0] * (g0 * sigmoidf_(g0)), y1 = o[ti][1] * rstd * wn[1] * (g1 * sigmoidf_(g1)), y2 = o[ti][2] * rstd * wn[2] * (g2 * sigmoidf_(g2)), y3 = o[ti][3] * rstd * wn[3] * (g3 * sigmoidf_(g3));
                *(u32x2_t*)(F.MIX + (row0 + (size_t)(ck * 64 + 16 * ti + l16)) * DM + h * HHD + 16 * w + 4 * g) = (u32x2_t){cvtpk(y0, y1), cvtpk(y2, y3)}; }
        } else { __syncthreads(); }
    }
    if (!FULL) {
#pragma unroll
        for (int q = 0; q < 8; ++q)
#pragma unroll
            for (int i = 0; i < 4; ++i) Sg[hpi(q, 4 * g + i) * 128 + 16 * w + l16] = S[q][i];
        if (w == 0) { F.Dg[unit * 128 + d0] = dsum0; F.Dg[unit * 128 + d0 + 1] = dsum1; }
    }
}
__device__ __forceinline__ void hgrn_scan(Frame& F) {
    for (int idx = F.vcu * 512 + F.tid; idx < 16 * 8192; idx += F.G * 512) { const int bh = idx >> 13, rem = idx & 8191, d = rem >> 6, e2 = rem & 63;
        f32x2_t S = {0.f, 0.f};
        for (int gI = 0; gI < 16; ++gI) { const int unit = bh * 16 + gI; const size_t off = (size_t)unit * 16384 + d * 128 + 2 * e2;
            *(f32x2_t*)(F.Sst + off) = S; const float dec = __builtin_amdgcn_exp2f(F.Dg[unit * 128 + d]); const f32x2_t nv = *(const f32x2_t*)(F.Send + off); S = S * dec + nv; } }
}
typedef float f32x16 __attribute__((ext_vector_type(16)));
constexpr int AL_K = 0, AL_V = 32768, AL_TAB = 65536, AL_WSF = 71680, AL_OST = 73728;
constexpr float ATT_C2 = 0.125f * 1.4426950408889634f, LOG2E = 1.4426950408889634f, ATT_NEG = -1.0e30f;
__device__ __forceinline__ int crow(int r, int hi) { return (r & 3) + 8 * (r >> 2) + 4 * hi; }
#define MFMA32(a, b, c) __builtin_amdgcn_mfma_f32_32x32x16_bf16((a), (b), (c), 0, 0, 0)
__device__ __forceinline__ void attn_unit(Frame& F, int unit) {
    const int kvh = unit & 3, n = (unit >> 2) & 63, b = unit >> 8;
    const int tid = F.tid, lane = F.lane, w = F.wave, r32 = lane & 31, hi = lane >> 5, qs = w & 3, hp = w >> 2;
    LAS unsigned char* L = F.lds + RING_OFF;
    const bf16* P = F.PROJ + (size_t)(b * SEQ) * INW;
#pragma unroll
    for (int kt = 0; kt < 4; ++kt) { const int row = tid >> 3, c8 = tid & 7, kpos = 128 * (n - 1) + 64 * kt + row;
        v4u kv = {0u, 0u, 0u, 0u}, vv = {0u, 0u, 0u, 0u};
        if (kpos >= 0) { kv = *(const v4u*)(P + (size_t)kpos * INW + COL_AK + kvh * AHD + c8 * 8); vv = *(const v4u*)(P + (size_t)kpos * INW + COL_AV + kvh * AHD + c8 * 8); }
        *(LAS v4u*)(L + AL_K + kt * 8192 + c8 * 1024 + row * 16) = kv;
        *(LAS v4u*)(L + AL_V + kt * 8192 + (c8 >> 2) * 4096 + (row >> 4) * 1024 + (row & 15) * 64 + (c8 & 3) * 16) = vv; }
#pragma unroll
    for (int i = 0; i < 3; ++i) { const int e = tid + 512 * i, hl = e / 384, idx = e - hl * 384, dist = idx - 127;
        float v = ATT_NEG; if (dist >= 0 && dist < 128) v = F.rel[T5_BUCKET[dist] * AQH + kvh * 4 + hl] * LOG2E;
        *(LAS float*)(L + AL_TAB + e * 4) = v; }
    __syncthreads();
    LAS float* wsf = (LAS float*)(L + AL_WSF) + w * 64;
    const int kt0 = qs >> 1;
#pragma unroll 1
    for (int hh = 0; hh < 2; ++hh) {
        const int hl = 2 * hp + hh, head = kvh * 4 + hl;
        bf16x8 qr[4];
        { const bf16* qp = P + (size_t)(128 * n + 32 * qs + r32) * INW + COL_AQ + head * AHD + hi * 8;
#pragma unroll
          for (int d0 = 0; d0 < 4; ++d0) qr[d0] = *(const bf16x8*)(qp + d0 * 16); }
        f32x16 s[3][2];
#pragma unroll
        for (int j = 0; j < 3; ++j) { const LAS unsigned char* kb = L + AL_K + (kt0 + j) * 8192 + hi * 1024 + r32 * 16;
#pragma unroll
            for (int d0 = 0; d0 < 4; ++d0) { const bf16x8 b0 = *(const LAS bf16x8*)(kb + d0 * 2048), b1 = *(const LAS bf16x8*)(kb + d0 * 2048 + 512);
                if (d0 == 0) { f32x16 z;
#pragma unroll
                    for (int r = 0; r < 16; ++r) z[r] = 0.f;
                    s[j][0] = MFMA32(b0, qr[0], z); s[j][1] = MFMA32(b1, qr[0], z); }
                else { s[j][0] = MFMA32(b0, qr[d0], s[j][0]); s[j][1] = MFMA32(b1, qr[d0], s[j][1]); } } }
        const float sink2 = F.sinks[head] * LOG2E;
        float mx = sink2;
#pragma unroll
        for (int j = 0; j < 3; ++j)
#pragma unroll
            for (int hf = 0; hf < 2; ++hf) { const bool dead = (n == 0) && (kt0 + j < 2);
                const int ibase = dead ? 126 : (32 * qs + r32 + 255 - 64 * (kt0 + j) - 4 * hi - 32 * hf);
                const LAS float* tp = (const LAS float*)(L + AL_TAB) + hl * 384 + ibase;
#pragma unroll
                for (int r = 0; r < 16; ++r) { const float v = s[j][hf][r] * ATT_C2 + tp[-((r & 3) + 8 * (r >> 2))]; s[j][hf][r] = v; mx = fmaxf(mx, v); } }
        mx = fmaxf(mx, __shfl_xor(mx, 32));
        float lsum = 0.f;
#pragma unroll
        for (int j = 0; j < 3; ++j)
#pragma unroll
            for (int hf = 0; hf < 2; ++hf)
#pragma unroll
                for (int r = 0; r < 16; ++r) { const float p = __builtin_amdgcn_exp2f(s[j][hf][r] - mx); s[j][hf][r] = p; lsum += p; }
        lsum += __shfl_xor(lsum, 32);
        lsum += __builtin_amdgcn_exp2f(sink2 - mx);
        if (hi == 0) wsf[32 + r32] = lsum;
        f32x16 o[2];
#pragma unroll
        for (int r = 0; r < 16; ++r) { o[0][r] = 0.f; o[1][r] = 0.f; }
#pragma unroll
        for (int j = 0; j < 3; ++j) { const LAS unsigned char* vb = L + AL_V + (kt0 + j) * 8192 + ((lane >> 4) & 1) * 32 + (lane & 3) * 8 + (4 * hi + ((lane & 15) >> 2)) * 64;
            bf16x8 pa[4];
#pragma unroll
            for (int k = 0; k < 4; ++k) { const f32x16& pp = s[j][k >> 1]; const int o8 = (k & 1) * 8;
                const v4u pk = {cvtpk(pp[o8 + 0], pp[o8 + 1]), cvtpk(pp[o8 + 2], pp[o8 + 3]), cvtpk(pp[o8 + 4], pp[o8 + 5]), cvtpk(pp[o8 + 6], pp[o8 + 7])}; pa[k] = __builtin_bit_cast(bf16x8, pk); }
#pragma unroll
            for (int d0 = 0; d0 < 2; ++d0)
#pragma unroll
                for (int ks = 0; ks < 4; ++ks) { const v4i16_t lo = vtr(vb + d0 * 4096 + ks * 1024), hv = vtr(vb + d0 * 4096 + ks * 1024 + 512);
                    const bf16x8 vfr = __builtin_shufflevector(lo, hv, 0, 1, 2, 3, 4, 5, 6, 7); o[d0] = MFMA32(pa[ks], vfr, o[d0]); } }
        asm volatile("s_waitcnt lgkmcnt(0)" ::: "memory");
        LAS bf16* stg = (LAS bf16*)(L + AL_OST) + w * 2048;
#pragma unroll
        for (int r = 0; r < 16; ++r) { const int orow = crow(r, hi); const float rl = __builtin_amdgcn_rcpf(wsf[32 + orow]);
#pragma unroll
            for (int d0 = 0; d0 < 2; ++d0) stg[orow * 64 + d0 * 32 + r32] = (bf16)f2bf(o[d0][r] * rl); }
        asm volatile("s_waitcnt lgkmcnt(0)" ::: "memory");
        bf16* Ow = F.MIX + (size_t)(b * SEQ + 128 * n + 32 * qs) * DM + HW + head * AHD;
#pragma unroll
        for (int i = 0; i < 4; ++i) { const int row = i * 8 + (lane >> 3), ch = lane & 7; const v4u v = *(const LAS v4u*)(stg + row * 64 + ch * 8); *(v4u*)(Ow + (size_t)row * DM + ch * 8) = v; }
        asm volatile("s_waitcnt lgkmcnt(0)" ::: "memory");
    }
    __syncthreads();
}

struct Args { const float* in[16]; float* out; unsigned char* ws; int ph_lo, ph_hi; };
constexpr int N_PHASES = 11;
__global__ void __launch_bounds__(NWAVES * 64, 2) mk_fwd(Args args) {
    extern __shared__ __attribute__((aligned(16))) unsigned char lds[];
    Frame F;
    F.lds = (LAS unsigned char*)lds;
    F.MISC = (volatile LAS unsigned*)(F.lds + MISC_OFF);
    F.tid = threadIdx.x; F.lane = F.tid & 63; F.wave = __builtin_amdgcn_readfirstlane(F.tid >> 6);
    F.G = gridDim.x; { const int bx = blockIdx.x; F.vcu = (F.G % 8 == 0) ? (bx % 8) * (F.G / 8) + bx / 8 : bx; }
    unsigned char* ws = args.ws;
    F.ctl = (gu32*)(ws + WS_CTL);
    F.x = args.in[0]; F.c = args.in[1]; F.w_ada = args.in[2]; F.b_ada = args.in[3]; F.norm1_w = args.in[4]; F.w_in = args.in[5]; F.lower_bounds = args.in[6]; F.hgrn_norm_w = args.in[7];
    F.sinks = args.in[8]; F.rel = args.in[9]; F.w_out = args.in[10]; F.norm2_w = args.in[11]; F.w_gate = args.in[12]; F.w_up = args.in[13]; F.w_down = args.in[14]; F.final_w = args.in[15];
    F.out = args.out; F.mod = (float*)(ws + WS_MOD);
    F.Wt_in = (bf16*)(ws + WS_WIN); F.Wt_out = (bf16*)(ws + WS_WOUT); F.Wt_gu = (bf16*)(ws + WS_WGU); F.Wt_dn = (bf16*)(ws + WS_WDN);
    F.Send = (float*)(ws + WS_SEND); F.Sst = (float*)(ws + WS_SST); F.Dg = (float*)(ws + WS_DG);
    F.H = (bf16*)(ws + WS_H); F.MIX = (bf16*)(ws + WS_MIX); F.PROJ = (bf16*)(ws + WS_PROJ);
    for (int u = F.tid; u < (LDS_BYTES - LDSCTL_OFF) / 4; u += NWAVES * 64) ((LAS unsigned*)(F.lds + LDSCTL_OFF))[u] = 0u;
    __syncthreads();
    const int lo = args.ph_lo, hi = args.ph_hi;
    const bool fused = (hi - lo) > 1;
    XcdBarrier bar; bar.bar = (unsigned*)(F.ctl + CW_BAR); bar.x = 0; bar.st = nullptr;
    if (fused) bar = xcd_barrier_post((unsigned*)(F.ctl + CW_BAR), F.MISC + 8);
#define IN(k) (lo <= (k) && (k) < hi)
#define SEAM(k) do { if (IN(k) && IN((k) + 1)) xcd_barrier(bar); } while (0)

#ifndef PROBE_MASK
#define PROBE_MASK 0
#endif
#define PHASE(k, ...) if (IN(k)) { _Pragma("nounroll") for (int rep_ = 0; rep_ <= ((PROBE_MASK >> (k)) & 1); ++rep_) { __VA_ARGS__ if (rep_ < ((PROBE_MASK >> (k)) & 1)) xcd_barrier(bar); } } SEAM(k);
    PHASE(0, p0a_prologue(F);)
    PHASE(1, norm_mod_pass(F, F.x, F.norm1_w, 0, DM, F.H);)
    PHASE(2, { pg8::Gemm g{F.H, F.Wt_in, M, INW, DM}; pg8::StaticOrder S; S.init(M, INW, F.G, (int)blockIdx.x);
        pg8::EpiBf16Plain E{F.PROJ, INW};
        pg8::gemm_phase<pg8::EpiBf16Plain, pg8::StaticOrder, true, true>(F.lds + RING_OFF, g, S, E); })
    PHASE(3, for (int u = F.vcu; u < 256; u += F.G) hgrn_group<false>(F, u);)
    PHASE(4, hgrn_scan(F); for (int u = F.vcu; u < BATCH * 64 * AKV; u += F.G) attn_unit(F, u);)
    PHASE(5, for (int u = F.vcu; u < 256; u += F.G) hgrn_group<true>(F, u);)
    PHASE(6, { pg8::Gemm g{F.MIX, F.Wt_out, M, DM, DM}; pg8::StaticOrder S; S.init(M, DM, F.G, (int)blockIdx.x);
        pg8::EpiResGate E{F.x, F.out, DM, F.mod + 2 * DM, F.b_ada + 2 * DM, MODW, SEQ / 256};
        pg8::gemm_phase<pg8::EpiResGate, pg8::StaticOrder, true, true>(F.lds + RING_OFF, g, S, E); })
    PHASE(7, norm_mod_pass(F, F.out, F.norm2_w, 3 * DM, 4 * DM, F.H);)
    PHASE(8, { pg8::Gemm g{F.H, F.Wt_gu, M, 2 * DFF, DM}; pg8::StaticOrder S; S.init(M, 2 * DFF, F.G, (int)blockIdx.x);
        pg8::EpiSwiGLU E{F.PROJ, DFF};
        pg8::gemm_phase<pg8::EpiSwiGLU, pg8::StaticOrder, true, true>(F.lds + RING_OFF, g, S, E); })
    PHASE(9, { pg8::Gemm g{F.PROJ, F.Wt_dn, M, DM, DFF}; pg8::StaticOrder S; S.init(M, DM, F.G, (int)blockIdx.x);
        pg8::EpiResGate E{F.out, F.out, DM, F.mod + 5 * DM, F.b_ada + 5 * DM, MODW, SEQ / 256};
        pg8::gemm_phase<pg8::EpiResGate, pg8::StaticOrder, true, true>(F.lds + RING_OFF, g, S, E); })
    if (IN(10)) { final_norm_pass(F); }
#undef PHASE
#undef IN
#undef SEAM
}

extern "C" void kernel_launch(void* const* d_in, const int* in_sizes, int n_in, void* d_out, int out_size, void* d_ws, size_t ws_size, hipStream_t stream) {
    static int grid = 0;
    if (grid == 0) {
        if (n_in != 16 || in_sizes[0] != M * DM || out_size != M * DM || ws_size < WS_END) { fprintf(stderr, "kernel_launch: unexpected shapes (n_in %d, in0 %d, out %d, ws %zu); nothing launched\n", n_in, n_in > 0 ? in_sizes[0] : -1, out_size, ws_size); grid = -1; return; }
        int dev = 0, cus = 0, per_cu = 0;
        if (hipGetDevice(&dev) != hipSuccess || hipDeviceGetAttribute(&cus, hipDeviceAttributeMultiprocessorCount, dev) != hipSuccess) { fprintf(stderr, "kernel_launch: device query failed\n"); grid = -1; return; }
        if (hipFuncSetAttribute((const void*)mk_fwd, hipFuncAttributeMaxDynamicSharedMemorySize, LDS_BYTES) != hipSuccess) { fprintf(stderr, "kernel_launch: hipFuncSetAttribute failed\n"); grid = -1; return; }
        if (hipOccupancyMaxActiveBlocksPerMultiprocessor(&per_cu, (const void*)mk_fwd, NWAVES * 64, LDS_BYTES) != hipSuccess || per_cu < 1) { fprintf(stderr, "kernel_launch: occupancy query reports %d blocks per CU; nothing launched\n", per_cu); (void)hipGetLastError(); grid = -1; return; }
        grid = cus;
        fprintf(stderr, "kernel_launch: grid %d (cus %d, occupancy %d per CU)\n", grid, cus, per_cu);
    }
    if (grid < 0) return;
    if (hipMemsetAsync((char*)d_ws + WS_CTL, 0, CTL_ZERO_BYTES, stream) != hipSuccess) { fprintf(stderr, "kernel_launch: memset failed\n"); return; }
    Args a{};
    for (int i = 0; i < 16; ++i) a.in[i] = (const float*)d_in[i];
    a.out = (float*)d_out; a.ws = (unsigned char*)d_ws;
#ifndef MK_N_LAUNCHES
#define MK_N_LAUNCHES 1
#endif
    if (MK_N_LAUNCHES == 1) { a.ph_lo = 0; a.ph_hi = N_PHASES; hipLaunchKernelGGL(mk_fwd, dim3(grid), dim3(NWAVES * 64), LDS_BYTES, stream, a); }
    else for (int p = 0; p < N_PHASES; ++p) { a.ph_lo = p; a.ph_hi = p + 1; hipLaunchKernelGGL(mk_fwd, dim3(grid), dim3(NWAVES * 64), LDS_BYTES, stream, a); }
    const hipError_t le = hipPeekAtLastError();
    if (le != hipSuccess) fprintf(stderr, "kernel_launch: launch failed: %s\n", hipGetErrorName(le));
}
```
